# Optimizing an MI355X kernel written in HIP

```python
import jax, jax.numpy as jnp
from jax import lax
import numpy as np

D_MODEL = 1024
BATCH = 8
SEQ = 8192
DEPTH = 2

GRID_W = 64
CTX_LEN = 256
N_MIXERS = 2
NORM_EPS = 1e-6
N_HEADS = 16
N_KV_HEADS = 4
HEAD_DIM = D_MODEL // N_HEADS
KV_GROUP = N_HEADS // N_KV_HEADS
Q_BLOCK = 128
ROPE_THETA = 10000.0
ROPE_PAIRS = HEAD_DIM // 4
RWKV_HEAD = 64
RWKV_HEADS = D_MODEL // RWKV_HEAD
DECAY_LORA = 64
ICLR_LORA = 64
GATE_LORA = 128
GN_EPS = 64e-5
D_FF = -(-8 * D_MODEL // (3 * 256)) * 256

kernel_name = "hybrid_gqa_rwkv7_prefix_dit"


def _rmsnorm(x, g):
    xf = x.astype(jnp.float32)
    y = xf * lax.rsqrt(jnp.mean(xf * xf, axis=-1, keepdims=True) + NORM_EPS)
    return (y * g.astype(jnp.float32)).astype(x.dtype)


def _axial_rope_tables(rows, dtype):
    L = rows * GRID_W
    row = jnp.repeat(jnp.arange(rows, dtype=jnp.float32), GRID_W, total_repeat_length=L)
    col = jnp.tile(jnp.arange(GRID_W, dtype=jnp.float32), rows)
    inv_freq = ROPE_THETA ** (-jnp.arange(ROPE_PAIRS, dtype=jnp.float32) / ROPE_PAIRS)
    ang = jnp.stack([row[:, None] * inv_freq, col[:, None] * inv_freq], axis=1)
    return jnp.cos(ang).astype(dtype), jnp.sin(ang).astype(dtype)


def _apply_axial_rope(x, cos, sin):
    xs = x.reshape(x.shape[:-1] + (2, 2, ROPE_PAIRS))
    x1, x2 = xs[..., 0, :], xs[..., 1, :]
    cb, sb = cos[None, :, None], sin[None, :, None]
    out = jnp.stack([x1 * cb - x2 * sb, x1 * sb + x2 * cb], axis=-2)
    return out.reshape(x.shape)


def _gqa_softmax(q, k, v):
    s = jnp.einsum('bqkgd,bskd->bkgqs', q, k).astype(jnp.float32) * (HEAD_DIM ** -0.5)
    p = jax.nn.softmax(s, axis=-1).astype(v.dtype)
    return jnp.einsum('bkgqs,bskd->bqkgd', p, v)


def _attention_mixer(h, hc, wqkv, q_gain, k_gain, wo, cos, sin, need_ctx):
    B, L, _ = h.shape
    C = hc.shape[1]
    nq = N_HEADS * HEAD_DIM
    nk = N_KV_HEADS * HEAD_DIM
    qkv = h @ wqkv
    q = qkv[..., :nq].reshape(B, L, N_HEADS, HEAD_DIM)
    k = qkv[..., nq:nq + nk].reshape(B, L, N_KV_HEADS, HEAD_DIM)
    v = qkv[..., nq + nk:].reshape(B, L, N_KV_HEADS, HEAD_DIM)
    q = _apply_axial_rope(_rmsnorm(q, q_gain), cos, sin)
    k = _apply_axial_rope(_rmsnorm(k, k_gain), cos, sin)
    qkv_c = hc @ (wqkv if need_ctx else wqkv[:, nq:])
    kv_c = qkv_c[..., -2 * nk:]
    k_c = _rmsnorm(kv_c[..., :nk].reshape(B, C, N_KV_HEADS, HEAD_DIM), k_gain)
    v_c = kv_c[..., nk:].reshape(B, C, N_KV_HEADS, HEAD_DIM)
    k_all = jnp.concatenate([k_c, k], axis=1)
    v_all = jnp.concatenate([v_c, v], axis=1)
    nb = L // Q_BLOCK
    q_blocks = q.reshape(B, nb, Q_BLOCK, N_KV_HEADS, KV_GROUP, HEAD_DIM).transpose(1, 0, 2, 3, 4, 5)
    o = lax.map(lambda qb: _gqa_softmax(qb, k_all, v_all), q_blocks)
    o = o.transpose(1, 0, 2, 3, 4, 5).reshape(B, L, nq)
    y = o @ wo
    yc = None
    if need_ctx:
        q_c = _rmsnorm(qkv_c[..., :nq].reshape(B, C, N_KV_HEADS, KV_GROUP, HEAD_DIM), q_gain)
        yc = _gqa_softmax(q_c, k_c, v_c).reshape(B, C, nq) @ wo
    return y, yc


def _centred_shift_delta(u):
    pad = jnp.pad(u, ((0, 0), (1, 1), (0, 0)))
    return 0.5 * (pad[:, :-2] + pad[:, 2:]) - u


def _rwkv_branches(u, mix, w_rkv, w0, w1, w2, a0, a1, a2, g1, g2, k_k, k_a, readout):
    B, T, _ = u.shape
    xx = _centred_shift_delta(u)

    def lerp(j):
        return u + xx * mix[j]

    sel = (0, 2, 3) if readout else (2, 3)
    proj = jnp.einsum('jbtd,jde->jbte', jnp.stack([lerp(s) for s in sel]), w_rkv[-len(sel):])
    k = proj[-2].astype(jnp.float32)

    def heads(z):
        return z.reshape(B, T, RWKV_HEADS, RWKV_HEAD).astype(jnp.float32)

    kk = heads(k * k_k)
    kk = kk * lax.rsqrt(jnp.maximum(jnp.sum(kk * kk, axis=-1, keepdims=True), 1e-24))
    xw, xa = lerp(1), lerp(4)
    dirs = []
    for d in range(2):
        w_log = -jax.nn.softplus(-(w0[d] + jnp.tanh(xw @ w1[d]) @ w2[d]).astype(jnp.float32)) - 0.5
        decay = jnp.exp(-jnp.exp(w_log))
        a = jax.nn.sigmoid((a0[d] + (xa @ a1[d]) @ a2[d]).astype(jnp.float32))
        k_d = k * (1.0 + (a - 1.0) * k_a)
        dirs.append((heads(decay), heads(k_d), heads(a)))
    r = heads(proj[0]) if readout else None
    g = (jax.nn.sigmoid(lerp(5) @ g1) @ g2) if readout else None
    return r, heads(proj[-1]), kk, dirs, g


def _wkv_scan(S0, decay, k, v, kk, a, r, reverse):
    xs = (decay, k, v, kk, a) + (() if r is None else (r,))

    def step(S, inp):
        w_t, k_t, v_t, kk_t, a_t = inp[:5]
        sa = jnp.einsum('bhvk,bhk->bhv', S, -kk_t)
        S = (S * w_t[:, :, None, :] + sa[..., None] * (kk_t * a_t)[:, :, None, :]
             + v_t[..., None] * k_t[:, :, None, :])
        y = jnp.einsum('bhvk,bhk->bhv', S, inp[5]) if len(inp) == 6 else None
        return S, y

    S, ys = lax.scan(step, S0, tuple(jnp.moveaxis(z, 1, 0) for z in xs), reverse=reverse)
    return S, (None if ys is None else jnp.moveaxis(ys, 0, 1))


def _rwkv_readout(wkv, r, v, k_dirs, g, r_k, ln_g, ln_b, wo, dtype):
    B, T, H, N = wkv.shape
    mu = jnp.mean(wkv, axis=-1, keepdims=True)
    var = jnp.mean(jnp.square(wkv - mu), axis=-1, keepdims=True)
    gn = ((wkv - mu) * lax.rsqrt(var + GN_EPS)).reshape(B, T, H * N) * ln_g + ln_b
    bonus = sum(jnp.sum(r * k_d * r_k, axis=-1, keepdims=True) for k_d in k_dirs) * v
    out = (gn + bonus.reshape(B, T, H * N)) * g
    return out.astype(dtype) @ wo


def _rwkv7_mixer(h, hc, mix, w_rkv, w0, w1, w2, a0, a1, a2, g1, g2, k_k, k_a, r_k,
                 ln_g, ln_b, wo, need_ctx):
    params = (mix, w_rkv, w0, w1, w2, a0, a1, a2, g1, g2, k_k, k_a)
    r, v, kk, dirs, g = _rwkv_branches(h, *params, readout=True)
    rc, vc, kkc, dirs_c, gc = _rwkv_branches(hc, *params, readout=need_ctx)
    B = h.shape[0]
    S0 = jnp.zeros((B, RWKV_HEADS, RWKV_HEAD, RWKV_HEAD), jnp.float32)
    wkv = 0.0
    wkv_c = 0.0
    for d, rev in enumerate((False, True)):
        decay_c, k_c, a_c = dirs_c[d]
        S_ctx, yc = _wkv_scan(S0, decay_c, k_c, vc, kkc, a_c, rc, rev)
        decay, k_d, a_d = dirs[d]
        _, y = _wkv_scan(S_ctx, decay, k_d, v, kk, a_d, r, rev)
        wkv = wkv + y
        if need_ctx:
            wkv_c = wkv_c + yc
    y = _rwkv_readout(wkv, r, v, [dd[1] for dd in dirs], g, r_k, ln_g, ln_b, wo, h.dtype)
    yc = None
    if need_ctx:
        yc = _rwkv_readout(wkv_c, rc, vc, [dd[1] for dd in dirs_c], gc, r_k, ln_g, ln_b, wo, hc.dtype)
    return y, yc


def _swiglu(h, wg, wu, wd):
    return (jax.nn.silu(h @ wg) * (h @ wu)) @ wd


def setup_inputs(seed: int = 0) -> dict:
    key = jax.random.key(seed)
    ks = iter(jax.random.split(key, 40))
    f32 = jnp.float32
    n_attn = len(range(0, DEPTH, N_MIXERS))
    n_rwkv = len(range(1, DEPTH, N_MIXERS))
    D = D_MODEL

    def nrm(shape, std):
        return jax.random.normal(next(ks), shape, f32) * std

    def unif(shape, lo, hi):
        return jax.random.uniform(next(ks), shape, f32, lo, hi)

    nqkv = (N_HEADS + 2 * N_KV_HEADS) * HEAD_DIM
    return {
        "x": nrm((BATCH, SEQ, D), 1.0),
        "c": nrm((BATCH, D), 1.0),
        "ctx": nrm((BATCH, CTX_LEN, D), 1.0),
        "c_ctx": nrm((D,), 1.0),
        "mod_w": nrm((DEPTH, D, 6 * D), 0.3 * D ** -0.5),
        "mod_b": nrm((DEPTH, 6 * D), 0.02),
        "norm1_g": 1.0 + nrm((DEPTH, D), 0.02),
        "norm2_g": 1.0 + nrm((DEPTH, D), 0.02),
        "ffn_wg": nrm((DEPTH, D, D_FF), D ** -0.5),
        "ffn_wu": nrm((DEPTH, D, D_FF), D ** -0.5),
        "ffn_wd": nrm((DEPTH, D_FF, D), D_FF ** -0.5),
        "attn_wqkv": nrm((n_attn, D, nqkv), D ** -0.5),
        "attn_q_gain": 1.0 + nrm((n_attn, HEAD_DIM), 0.02),
        "attn_k_gain": 1.0 + nrm((n_attn, HEAD_DIM), 0.02),
        "attn_wo": nrm((n_attn, N_HEADS * HEAD_DIM, D), (N_HEADS * HEAD_DIM) ** -0.5),
        "rwkv_mix": unif((n_rwkv, 6, D), 0.0, 1.0),
        "rwkv_wrkv": nrm((n_rwkv, 3, D, D), D ** -0.5),
        "rwkv_w0": unif((n_rwkv, 2, D), -6.0, -1.0),
        "rwkv_w1": nrm((n_rwkv, 2, D, DECAY_LORA), D ** -0.5),
        "rwkv_w2": nrm((n_rwkv, 2, DECAY_LORA, D), 0.5 * DECAY_LORA ** -0.5),
        "rwkv_a0": nrm((n_rwkv, 2, D), 0.1),
        "rwkv_a1": nrm((n_rwkv, 2, D, ICLR_LORA), D ** -0.5),
        "rwkv_a2": nrm((n_rwkv, 2, ICLR_LORA, D), 0.5 * ICLR_LORA ** -0.5),
        "rwkv_g1": nrm((n_rwkv, D, GATE_LORA), D ** -0.5),
        "rwkv_g2": nrm((n_rwkv, GATE_LORA, D), GATE_LORA ** -0.5),
        "rwkv_k_k": 0.85 + nrm((n_rwkv, D), 0.05),
        "rwkv_k_a": 1.0 + nrm((n_rwkv, D), 0.05),
        "rwkv_r_k": nrm((n_rwkv, RWKV_HEADS, RWKV_HEAD), 0.1),
        "rwkv_ln_g": 1.0 + nrm((n_rwkv, D), 0.02),
        "rwkv_ln_b": nrm((n_rwkv, D), 0.02),
        "rwkv_wo": nrm((n_rwkv, D, D), D ** -0.5),
        "final_g": 1.0 + nrm((D,), 0.02),
    }


def reference(x, c, ctx, c_ctx, mod_w, mod_b, norm1_g, norm2_g, ffn_wg, ffn_wu, ffn_wd,
              attn_wqkv, attn_q_gain, attn_k_gain, attn_wo,
              rwkv_mix, rwkv_wrkv, rwkv_w0, rwkv_w1, rwkv_w2, rwkv_a0, rwkv_a1, rwkv_a2,
              rwkv_g1, rwkv_g2, rwkv_k_k, rwkv_k_a, rwkv_r_k, rwkv_ln_g, rwkv_ln_b, rwkv_wo,
              final_g):
    B, L, D = x.shape
    rows = L // GRID_W
    cos, sin = _axial_rope_tables(rows, x.dtype)
    sc = jax.nn.silu(c)
    scc = jax.nn.silu(c_ctx)
    xc = ctx
    for i in range(DEPTH):
        last = i == DEPTH - 1
        j = i // N_MIXERS
        m = (sc @ mod_w[i] + mod_b[i]).reshape(B, 6, 1, D)
        mc = (scc @ mod_w[i] + mod_b[i]).reshape(6, D)
        h = _rmsnorm(x, norm1_g[i]) * (1.0 + m[:, 1]) + m[:, 0]
        hc = _rmsnorm(xc, norm1_g[i]) * (1.0 + mc[1]) + mc[0]
        if i % N_MIXERS == 0:
            y, yc = _attention_mixer(h, hc, attn_wqkv[j], attn_q_gain[j], attn_k_gain[j],
                                     attn_wo[j], cos, sin, not last)
        else:
            y, yc = _rwkv7_mixer(h, hc, rwkv_mix[j], rwkv_wrkv[j], rwkv_w0[j], rwkv_w1[j],
                                 rwkv_w2[j], rwkv_a0[j], rwkv_a1[j], rwkv_a2[j], rwkv_g1[j],
                                 rwkv_g2[j], rwkv_k_k[j], rwkv_k_a[j], rwkv_r_k[j],
                                 rwkv_ln_g[j], rwkv_ln_b[j], rwkv_wo[j], not last)
        x = x + m[:, 2] * y
        h2 = _rmsnorm(x, norm2_g[i]) * (1.0 + m[:, 4]) + m[:, 3]
        x = x + m[:, 5] * _swiglu(h2, ffn_wg[i], ffn_wu[i], ffn_wd[i])
        if not last:
            xc = xc + mc[2] * yc
            hc2 = _rmsnorm(xc, norm2_g[i]) * (1.0 + mc[4]) + mc[3]
            xc = xc + mc[5] * _swiglu(hc2, ffn_wg[i], ffn_wu[i], ffn_wd[i])
    return _rmsnorm(x, final_g)
```

```cpp
#include <hip/hip_runtime.h>
#include <hip/hip_cooperative_groups.h>
#include <cstdint>
#include <cstdio>
namespace cg = cooperative_groups;

#ifndef MULTI_LAUNCH
#define MULTI_LAUNCH 0
#endif

typedef unsigned short bf16_t;
typedef short bf16x8 __attribute__((ext_vector_type(8)));
typedef float f32x4 __attribute__((ext_vector_type(4)));

#define NB 8
#define SEQL 8192
#define CTXL 256
#define PB 8448
#define RT (NB * PB)
#define DM 1024
#define DFF 2816
#define NTHR 512

constexpr size_t U = (size_t)RT * 1024 * 2;
constexpr size_t OFF_WQKV = 0;
constexpr size_t OFF_AWO = OFF_WQKV + (size_t)1536 * 1024 * 2;
constexpr size_t OFF_GU = OFF_AWO + (size_t)1024 * 1024 * 2;
constexpr size_t OFF_WD = OFF_GU + (size_t)2 * 5632 * 1024 * 2;
constexpr size_t OFF_WRKV = OFF_WD + (size_t)2 * 1024 * 2816 * 2;
constexpr size_t OFF_W1T = OFF_WRKV + (size_t)3 * 1024 * 1024 * 2;
constexpr size_t OFF_A1T = OFF_W1T + (size_t)128 * 1024 * 2;
constexpr size_t OFF_G1T = OFF_A1T + (size_t)128 * 1024 * 2;
constexpr size_t OFF_W2T = OFF_G1T + (size_t)128 * 1024 * 2;
constexpr size_t OFF_A2T = OFF_W2T + (size_t)2 * 1024 * 64 * 2;
constexpr size_t OFF_G2T = OFF_A2T + (size_t)2 * 1024 * 64 * 2;
constexpr size_t OFF_RWO = OFF_G2T + (size_t)1024 * 128 * 2;
constexpr size_t OFF_MOD = OFF_RWO + (size_t)1024 * 1024 * 2;
constexpr size_t OFF_ROPE = OFF_MOD + (size_t)2 * 9 * 6144 * 4;
constexpr size_t OFF_KKN = OFF_ROPE + (size_t)2 * 128 * 16 * 4;
constexpr size_t OFF_BS = OFF_KKN + (size_t)RT * 16 * 4;
constexpr size_t OFF_XC = OFF_BS + (size_t)2 * RT * 16 * 4;
constexpr size_t OFF_ACTR = OFF_XC + (size_t)NB * CTXL * DM * 4;
constexpr size_t A0_H = OFF_ACTR, A0_Q = A0_H + U, A0_K = A0_Q + U, A0_VT = A0_K + U / 4, A0_O = A0_VT + U / 4, A0_ACT = A0_O + U;
constexpr size_t A1_H = OFF_ACTR, A1_XX = A1_H + U, A1_R = A1_XX + U, A1_K = A1_R + U, A1_V = A1_K + U, A1_TW = A1_V + U, A1_TA = A1_TW + U / 8,
                 A1_GH = A1_TA + U / 8;
constexpr size_t A1_Y0 = OFF_ACTR, A1_Y1 = OFF_ACTR + U, A1_Z = A1_R, A1_H2 = OFF_ACTR, A1_ACT = A1_K;
constexpr size_t WS_NEED = A0_ACT + (size_t)RT * DFF * 2;

constexpr int LDS_BYTES = 2 * (256 + 128) * 72 * 2;

struct Pm {
    const float *x, *c, *ctx, *c_ctx, *mod_w, *mod_b, *n1g, *n2g, *wg, *wu, *wd, *wqkv, *qg, *kg, *awo, *mix, *wrkv, *w0, *w1, *w2, *a0, *a1, *a2, *g1,
        *g2, *k_k, *k_a, *r_k, *lng, *lnb, *rwo, *fg;
    float* out;
    char* ws;
    int plo, phi;
};

typedef __bf16 bf16v2_t __attribute__((ext_vector_type(2)));
typedef float f32v2_t __attribute__((ext_vector_type(2)));
__device__ __forceinline__ unsigned pk2(float lo, float hi) {
    f32v2_t f = {lo, hi};
    bf16v2_t v = __builtin_convertvector(f, bf16v2_t);
    return __builtin_bit_cast(unsigned, v);
}
__device__ __forceinline__ bf16_t f2bf(float f) { return (bf16_t)(pk2(f, 0.f) & 0xffffu); }
__device__ __forceinline__ float bflo(unsigned u) { return __uint_as_float(u << 16); }
__device__ __forceinline__ float bfhi(unsigned u) { return __uint_as_float(u & 0xffff0000u); }
__device__ __forceinline__ void st4bf(bf16_t* p, float a, float b, float c, float d) { *(uint2*)p = make_uint2(pk2(a, b), pk2(c, d)); }
__device__ __forceinline__ void st4bf(bf16_t* p, f32x4 v) { st4bf(p, v[0], v[1], v[2], v[3]); }
__device__ __forceinline__ f32x4 ld4bf(const bf16_t* p) {
    uint2 u = *(const uint2*)p;
    return (f32x4){bflo(u.x), bfhi(u.x), bflo(u.y), bfhi(u.y)};
}
__device__ __forceinline__ float xsum16_32(float v) {
    v += __shfl_xor(v, 16);
    v += __shfl_xor(v, 32);
    return v;
}
__device__ __forceinline__ float xmax16_32(float v) {
    v = fmaxf(v, __shfl_xor(v, 16));
    v = fmaxf(v, __shfl_xor(v, 32));
    return v;
}
__device__ __forceinline__ float wave_sum(float v) {
#pragma unroll
    for (int o = 32; o >= 1; o >>= 1) v += __shfl_xor(v, o);
    return v;
}
__device__ __forceinline__ float fsigmoid(float x) { return 1.0f / (1.0f + __expf(-x)); }
__device__ __forceinline__ float fsilu(float x) { return x / (1.0f + __expf(-x)); }
__device__ __forceinline__ float ftanh(float x) {
    float e = __expf(-2.0f * fabsf(x));
    float t = (1.0f - e) / (1.0f + e);
    return x < 0.f ? -t : t;
}
template <class T> __device__ __forceinline__ T* xrow(T* lat, T* ctxp, int r) {
    int b = r / PB, p = r - b * PB;
    return p < CTXL ? ctxp + (size_t)(b * CTXL + p) * DM : lat + (size_t)(b * SEQL + (p - CTXL)) * DM;
}
__device__ __forceinline__ int modrow(int r) {
    int b = r / PB, p = r - b * PB;
    return p < CTXL ? 8 : b;
}

__device__ __forceinline__ void conv_tile(const float* src, bf16_t* dst, int K, int N, int mode, int roff, int t, float* tl) {
    const int tid = threadIdx.x;
    const int ntn = N >> 6;
    const int tk = t / ntn, tn = t - tk * ntn, k0 = tk * 64, n0 = tn * 64;
    __syncthreads();
#pragma unroll
    for (int i = 0; i < 8; ++i) {
        int k = (tid >> 6) + 8 * i;
        tl[k * 65 + (tid & 63)] = src[(size_t)(k0 + k) * N + n0 + (tid & 63)];
    }
    __syncthreads();
#pragma unroll
    for (int i = 0; i < 8; ++i) {
        int n = (tid >> 6) + 8 * i, ng = n0 + n;
        int drow = mode ? ((ng >> 4) * 32 + (ng & 15) + roff) : (ng + roff);
        dst[(size_t)drow * K + k0 + (tid & 63)] = f2bf(tl[(tid & 63) * 65 + n]);
    }
}

__device__ void phase0(const Pm& p, char* smem) {
    const int tid = threadIdx.x, G = gridDim.x;
    char* ws = p.ws;
    float* fl = (float*)smem;
    if (blockIdx.x < 192) {
        float* s = fl;
        float* red = fl + 9 * 1024;
        for (int idx = tid; idx < 9 * 1024; idx += NTHR) {
            int r = idx >> 10, k = idx & 1023;
            float v = r < 8 ? p.c[r * 1024 + k] : p.c_ctx[k];
            s[idx] = fsilu(v);
        }
        __syncthreads();
        for (int it = blockIdx.x; it < 192; it += G) {
            const int l = it / 96, q = it - l * 96;
            const int col = q * 64 + (tid & 63), kg = tid >> 6;
            const float* wp = p.mod_w + (size_t)l * 1024 * 6144 + col;
            float acc[9];
#pragma unroll
            for (int r = 0; r < 9; ++r) acc[r] = 0.f;
#pragma unroll 8
            for (int kk = 0; kk < 128; ++kk) {
                int k = kg * 128 + kk;
                float w = wp[(size_t)k * 6144];
#pragma unroll
                for (int r = 0; r < 9; ++r) acc[r] += s[r * 1024 + k] * w;
            }
#pragma unroll
            for (int r = 0; r < 9; ++r) red[(kg * 9 + r) * 64 + (tid & 63)] = acc[r];
            __syncthreads();
            for (int idx = tid; idx < 9 * 64; idx += NTHR) {
                int r = idx >> 6, cc = idx & 63;
                float v = 0.f;
#pragma unroll
                for (int g8 = 0; g8 < 8; ++g8) v += red[(g8 * 9 + r) * 64 + cc];
                int cg_ = q * 64 + cc;
                ((float*)(ws + OFF_MOD))[((size_t)l * 9 + r) * 6144 + cg_] = v + p.mod_b[l * 6144 + cg_];
            }
            __syncthreads();
        }
    }
    if (blockIdx.x == G - 1) {
        float* rt = (float*)(ws + OFF_ROPE);
        for (int idx = tid; idx < 2048; idx += NTHR) {
            int pos = idx >> 4, pi = idx & 15;
            float inv = powf(10000.0f, -(float)pi / 16.0f);
            float ang = (float)pos * inv;
            rt[idx] = cosf(ang);
            rt[2048 + idx] = sinf(ang);
        }
    }
    int cur = blockIdx.x, base = 0;
    auto job = [&](const float* src, bf16_t* dst, int K, int N, int mode, int roff) {
        int n = (K >> 6) * (N >> 6);
        while (cur < base + n) {
            conv_tile(src, dst, K, N, mode, roff, cur - base, fl);
            cur += G;
        }
        base += n;
    };
    job(p.wqkv, (bf16_t*)(ws + OFF_WQKV), 1024, 1536, 0, 0);
    job(p.awo, (bf16_t*)(ws + OFF_AWO), 1024, 1024, 0, 0);
    for (int l = 0; l < 2; ++l) {
        job(p.wg + (size_t)l * 1024 * DFF, (bf16_t*)(ws + OFF_GU) + (size_t)l * 5632 * 1024, 1024, DFF, 1, 0);
        job(p.wu + (size_t)l * 1024 * DFF, (bf16_t*)(ws + OFF_GU) + (size_t)l * 5632 * 1024, 1024, DFF, 1, 16);
        job(p.wd + (size_t)l * DFF * 1024, (bf16_t*)(ws + OFF_WD) + (size_t)l * 1024 * DFF, DFF, 1024, 0, 0);
    }
    for (int j = 0; j < 3; ++j) job(p.wrkv + (size_t)j * 1024 * 1024, (bf16_t*)(ws + OFF_WRKV) + (size_t)j * 1024 * 1024, 1024, 1024, 0, 0);
    for (int d = 0; d < 2; ++d) {
        job(p.w1 + (size_t)d * 1024 * 64, (bf16_t*)(ws + OFF_W1T), 1024, 64, 0, d * 64);
        job(p.a1 + (size_t)d * 1024 * 64, (bf16_t*)(ws + OFF_A1T), 1024, 64, 0, d * 64);
        job(p.w2 + (size_t)d * 64 * 1024, (bf16_t*)(ws + OFF_W2T) + (size_t)d * 1024 * 64, 64, 1024, 0, 0);
        job(p.a2 + (size_t)d * 64 * 1024, (bf16_t*)(ws + OFF_A2T) + (size_t)d * 1024 * 64, 64, 1024, 0, 0);
    }
    job(p.g1, (bf16_t*)(ws + OFF_G1T), 1024, 128, 0, 0);
    job(p.g2, (bf16_t*)(ws + OFF_G2T), 128, 1024, 0, 0);
    job(p.rwo, (bf16_t*)(ws + OFF_RWO), 1024, 1024, 0, 0);
}

__device__ __forceinline__ void norm_row(const float* xr, const float* g, const float* msh, const float* msc, f32x4 (&h)[4], int lane) {
    f32x4 v[4];
    float ss = 0.f;
#pragma unroll
    for (int i = 0; i < 4; ++i) {
        v[i] = *(const f32x4*)(xr + lane * 4 + i * 256);
        ss += v[i][0] * v[i][0] + v[i][1] * v[i][1] + v[i][2] * v[i][2] + v[i][3] * v[i][3];
    }
    ss = wave_sum(ss);
    const float rstd = rsqrtf(ss * (1.0f / 1024.0f) + 1e-6f);
#pragma unroll
    for (int i = 0; i < 4; ++i) {
        f32x4 gg = *(const f32x4*)(g + lane * 4 + i * 256);
        f32x4 sh = *(const f32x4*)(msh + lane * 4 + i * 256);
        f32x4 sc = *(const f32x4*)(msc + lane * 4 + i * 256);
        h[i] = (v[i] * rstd) * gg * (sc + 1.0f) + sh;
    }
}

template <int SHIFT>
__device__ void norm_phase(const float* lat, const float* ctxp, const float* g, const float* modl, int shI, int scI, bf16_t* H, bf16_t* XX, bool lat_only) {
    const int lane = threadIdx.x & 63, w = threadIdx.x >> 6;
    const int nw = gridDim.x * 8;
    for (int row = blockIdx.x * 8 + w; row < RT; row += nw) {
        const int b = row / PB, pp = row - b * PB;
        if (lat_only && pp < CTXL) continue;
        const int mr = pp < CTXL ? 8 : b;
        const float* msh = modl + (size_t)mr * 6144 + shI * 1024;
        const float* msc = modl + (size_t)mr * 6144 + scI * 1024;
        f32x4 h[4];
        norm_row(xrow(lat, ctxp, row), g, msh, msc, h, lane);
#pragma unroll
        for (int i = 0; i < 4; ++i) st4bf(H + (size_t)row * DM + lane * 4 + i * 256, h[i]);
        if (SHIFT) {
            f32x4 hp[4], hn[4];
            const bool hasP = !(pp == 0 || pp == CTXL), hasN = !(pp == CTXL - 1 || pp == PB - 1);
            if (hasP) norm_row(xrow(lat, ctxp, row - 1), g, msh, msc, hp, lane);
            else {
#pragma unroll
                for (int i = 0; i < 4; ++i) hp[i] = (f32x4){0.f, 0.f, 0.f, 0.f};
            }
            if (hasN) norm_row(xrow(lat, ctxp, row + 1), g, msh, msc, hn, lane);
            else {
#pragma unroll
                for (int i = 0; i < 4; ++i) hn[i] = (f32x4){0.f, 0.f, 0.f, 0.f};
            }
#pragma unroll
            for (int i = 0; i < 4; ++i) st4bf(XX + (size_t)row * DM + lane * 4 + i * 256, (hp[i] + hn[i]) * 0.5f - h[i]);
        }
    }
}

__device__ void final_norm_phase(float* X, const float* g) {
    const int lane = threadIdx.x & 63, w = threadIdx.x >> 6;
    const int nw = gridDim.x * 8;
    for (int row = blockIdx.x * 8 + w; row < NB * SEQL; row += nw) {
        float* xr = X + (size_t)row * DM;
        f32x4 v[4];
        float ss = 0.f;
#pragma unroll
        for (int i = 0; i < 4; ++i) {
            v[i] = *(const f32x4*)(xr + lane * 4 + i * 256);
            ss += v[i][0] * v[i][0] + v[i][1] * v[i][1] + v[i][2] * v[i][2] + v[i][3] * v[i][3];
        }
        ss = wave_sum(ss);
        const float rstd = rsqrtf(ss * (1.0f / 1024.0f) + 1e-6f);
#pragma unroll
        for (int i = 0; i < 4; ++i) {
            f32x4 gg = *(const f32x4*)(g + lane * 4 + i * 256);
            *(f32x4*)(xr + lane * 4 + i * 256) = (v[i] * rstd) * gg;
        }
    }
}

struct GemmArgs {
    const bf16_t* A;
    const bf16_t* A2;
    const float* mix;
    const bf16_t* Bt;
    int K, lda;
};

template <int AMODE>
__device__ __forceinline__ void gemm_main(const GemmArgs g, int tm, int tn, f32x4 (&acc)[4][4], char* smem) {
    const bf16_t* const gA = g.A; const bf16_t* const gA2 = g.A2; const float* const gmix = g.mix; const bf16_t* const gBt = g.Bt; const int lda = g.lda;
    const int tid = threadIdx.x, lane = tid & 63, w = tid >> 6;
    const int wr = w >> 1, wc = w & 1, fr = lane & 15, fq = lane >> 4;
    bf16_t* As = (bf16_t*)smem;
    bf16_t* Bs = As + 2 * 256 * 72;
    const int K = g.K, nk = K >> 6;
#pragma unroll
    for (int mi = 0; mi < 4; ++mi)
#pragma unroll
        for (int ni = 0; ni < 4; ++ni) acc[mi][ni] = (f32x4){0.f, 0.f, 0.f, 0.f};
    uint4 ra0, ra1, ra2, ra3, rb0, rb1;
    const int arow = tid >> 3, akc = (tid & 7) * 8;
    const bf16_t* Ap = gA + (size_t)(tm * 256 + arow) * lda + akc;
    const bf16_t* A2p = AMODE ? gA2 + (size_t)(tm * 256 + arow) * lda + akc : nullptr;
    const bf16_t* Bp = gBt + (size_t)(tn * 128 + arow) * K + akc;
#define GLOAD_A(R, I, KT)                                                                                         \
    {                                                                                                             \
        uint4 hv = *(const uint4*)(Ap + (size_t)(I) * 64 * lda + (KT) * 64);                                      \
        if (AMODE) {                                                                                              \
            uint4 xv = *(const uint4*)(A2p + (size_t)(I) * 64 * lda + (KT) * 64);                                 \
            f32x4 m0 = *(const f32x4*)(gmix + (KT) * 64 + akc), m1 = *(const f32x4*)(gmix + (KT) * 64 + akc + 4); \
            hv.x = pk2(bflo(hv.x) + bflo(xv.x) * m0[0], bfhi(hv.x) + bfhi(xv.x) * m0[1]);                         \
            hv.y = pk2(bflo(hv.y) + bflo(xv.y) * m0[2], bfhi(hv.y) + bfhi(xv.y) * m0[3]);                         \
            hv.z = pk2(bflo(hv.z) + bflo(xv.z) * m1[0], bfhi(hv.z) + bfhi(xv.z) * m1[1]);                         \
            hv.w = pk2(bflo(hv.w) + bflo(xv.w) * m1[2], bfhi(hv.w) + bfhi(xv.w) * m1[3]);                         \
        }                                                                                                         \
        R = hv;                                                                                                   \
    }
#define GLOAD(KT)                                                \
    GLOAD_A(ra0, 0, KT) GLOAD_A(ra1, 1, KT) GLOAD_A(ra2, 2, KT) GLOAD_A(ra3, 3, KT) \
    rb0 = *(const uint4*)(Bp + (KT) * 64);                       \
    rb1 = *(const uint4*)(Bp + (size_t)64 * K + (KT) * 64);
#define LSTORE(BUF)                                                                  \
    {                                                                                \
        bf16_t* a_ = As + (size_t)(BUF) * 256 * 72 + arow * 72 + akc;                \
        *(uint4*)(a_) = ra0;                                                         \
        *(uint4*)(a_ + 64 * 72) = ra1;                                               \
        *(uint4*)(a_ + 128 * 72) = ra2;                                              \
        *(uint4*)(a_ + 192 * 72) = ra3;                                              \
        bf16_t* b_ = Bs + (size_t)(BUF) * 128 * 72 + arow * 72 + akc;                \
        *(uint4*)(b_) = rb0;                                                         \
        *(uint4*)(b_ + 64 * 72) = rb1;                                               \
    }
    GLOAD(0)
    __syncthreads();
    LSTORE(0)
    __syncthreads();
    for (int kt = 0; kt < nk; ++kt) {
        const int cur = kt & 1;
        if (kt + 1 < nk) { GLOAD(kt + 1) }
        const bf16_t* Ab = As + (size_t)cur * 256 * 72 + (wr * 64 + fr) * 72 + fq * 8;
        const bf16_t* Bb = Bs + (size_t)cur * 128 * 72 + (wc * 64 + fr) * 72 + fq * 8;
#pragma unroll
        for (int ks = 0; ks < 2; ++ks) {
            bf16x8 af[4], bf[4];
#pragma unroll
            for (int mi = 0; mi < 4; ++mi) af[mi] = *(const bf16x8*)(Ab + mi * 16 * 72 + ks * 32);
#pragma unroll
            for (int ni = 0; ni < 4; ++ni) bf[ni] = *(const bf16x8*)(Bb + ni * 16 * 72 + ks * 32);
#pragma unroll
            for (int mi = 0; mi < 4; ++mi)
#pragma unroll
                for (int ni = 0; ni < 4; ++ni) acc[mi][ni] = __builtin_amdgcn_mfma_f32_16x16x32_bf16(bf[ni], af[mi], acc[mi][ni], 0, 0, 0);
        }
        if (kt + 1 < nk) LSTORE(cur ^ 1)
        __syncthreads();
    }
}

__device__ __forceinline__ void epi_qkv(f32x4 (&acc)[4][4], int row0, int col0, int lane, bf16_t* Q, bf16_t* Kx, bf16_t* VT, const float* qg, const float* kg,
                                        const float* rope) {
    const int fr = lane & 15, fq = lane >> 4;
    if (col0 >= 1280) {
        const int kvh = (col0 - 1280) >> 6;
#pragma unroll
        for (int mi = 0; mi < 4; ++mi) {
            const int row = row0 + mi * 16 + fr, b = row / PB, pp = row - b * PB;
            bf16_t* vb = VT + ((size_t)(b * 4 + kvh) * 64) * PB + pp;
#pragma unroll
            for (int ni = 0; ni < 4; ++ni)
#pragma unroll
                for (int j = 0; j < 4; ++j) vb[(size_t)(ni * 16 + fq * 4 + j) * PB] = f2bf(acc[mi][ni][j]);
        }
        return;
    }
    const bool isq = col0 < 1024;
    const float* gain = isq ? qg : kg;
    f32x4 gv[4];
#pragma unroll
    for (int ni = 0; ni < 4; ++ni) gv[ni] = *(const f32x4*)(gain + ni * 16 + fq * 4);
#pragma unroll
    for (int mi = 0; mi < 4; ++mi) {
        float ss = 0.f;
#pragma unroll
        for (int ni = 0; ni < 4; ++ni)
#pragma unroll
            for (int j = 0; j < 4; ++j) ss += acc[mi][ni][j] * acc[mi][ni][j];
        ss = xsum16_32(ss);
        const float rstd = rsqrtf(ss * (1.0f / 64.0f) + 1e-6f);
        f32x4 v[4];
#pragma unroll
        for (int ni = 0; ni < 4; ++ni) v[ni] = (acc[mi][ni] * rstd) * gv[ni];
        const int row = row0 + mi * 16 + fr, b = row / PB, pp = row - b * PB;
        if (pp >= CTXL) {
            const int l = pp - CTXL, prow = l >> 6, pcol = l & 63;
#pragma unroll
            for (int a = 0; a < 2; ++a) {
                const int pos = a ? pcol : prow;
                f32x4 cs = *(const f32x4*)(rope + pos * 16 + fq * 4), sn = *(const f32x4*)(rope + 2048 + pos * 16 + fq * 4);
                f32x4 x1 = v[2 * a], x2 = v[2 * a + 1];
                v[2 * a] = x1 * cs - x2 * sn;
                v[2 * a + 1] = x1 * sn + x2 * cs;
            }
        }
        if (isq) {
#pragma unroll
            for (int ni = 0; ni < 4; ++ni) st4bf(Q + (size_t)row * 1024 + col0 + ni * 16 + fq * 4, v[ni]);
        } else {
#pragma unroll
            for (int ni = 0; ni < 4; ++ni) st4bf(Kx + (size_t)row * 256 + (col0 - 1024) + ni * 16 + fq * 4, v[ni]);
        }
    }
}

__device__ __forceinline__ void epi_res(f32x4 (&acc)[4][4], int row0, int col0, int lane, const float* slat, const float* sctx, float* dlat, float* dctx,
                                        const float* modl, int gI, float dbg_scale = 1.0f) {
    const int fr = lane & 15, fq = lane >> 4;
#pragma unroll
    for (int mi = 0; mi < 4; ++mi) {
        const int row = row0 + mi * 16 + fr;
        const float* sp = xrow(slat, sctx, row);
        float* dp = xrow(dlat, dctx, row);
        const float* gp = modl + (size_t)modrow(row) * 6144 + gI * 1024;
#pragma unroll
        for (int ni = 0; ni < 4; ++ni) {
            const int col = col0 + ni * 16 + fq * 4;
            f32x4 s = *(const f32x4*)(sp + col), gt = *(const f32x4*)(gp + col);
            f32x4 av = acc[mi][ni];
#ifdef DBG_CLAMPY
            for (int j = 0; j < 4; ++j) av[j] = fminf(fmaxf(av[j], -1.f), 1.f);
#endif
#ifdef DBG_CLAMPG
            for (int j = 0; j < 4; ++j) gt[j] = fminf(fmaxf(gt[j], -1.f), 1.f);
#endif
            *(f32x4*)(dp + col) = s + gt * av * dbg_scale;
        }
    }
}

__device__ __forceinline__ void epi_swiglu(f32x4 (&acc)[4][4], int row0, int col0, int lane, bf16_t* ACT) {
    const int fr = lane & 15, fq = lane >> 4;
#pragma unroll
    for (int mi = 0; mi < 4; ++mi) {
        const int row = row0 + mi * 16 + fr;
#pragma unroll
        for (int h2 = 0; h2 < 2; ++h2) {
            f32x4 gt = acc[mi][2 * h2], up = acc[mi][2 * h2 + 1], o;
#pragma unroll
            for (int j = 0; j < 4; ++j) o[j] = fsilu(gt[j]) * up[j];
            st4bf(ACT + (size_t)row * DFF + (col0 >> 1) + h2 * 16 + fq * 4, o);
        }
    }
}

template <int ACTF>
__device__ __forceinline__ void epi_store(f32x4 (&acc)[4][4], int row0, int col0, int lane, bf16_t* O, int ldo) {
    const int fr = lane & 15, fq = lane >> 4;
#pragma unroll
    for (int mi = 0; mi < 4; ++mi) {
        const int row = row0 + mi * 16 + fr;
#pragma unroll
        for (int ni = 0; ni < 4; ++ni) {
            f32x4 v = acc[mi][ni];
            if (ACTF == 1) {
#pragma unroll
                for (int j = 0; j < 4; ++j) v[j] = ftanh(v[j]);
            }
            if (ACTF == 2) {
#pragma unroll
                for (int j = 0; j < 4; ++j) v[j] = fsigmoid(v[j]);
            }
            st4bf(O + (size_t)row * ldo + col0 + ni * 16 + fq * 4, v);
        }
    }
}

__device__ __forceinline__ void epi_kstore(f32x4 (&acc)[4][4], int row0, int col0, int lane, bf16_t* O, const float* k_k, float* KKN) {
    const int fr = lane & 15, fq = lane >> 4;
    f32x4 kkv[4];
#pragma unroll
    for (int ni = 0; ni < 4; ++ni) kkv[ni] = *(const f32x4*)(k_k + col0 + ni * 16 + fq * 4);
#pragma unroll
    for (int mi = 0; mi < 4; ++mi) {
        const int row = row0 + mi * 16 + fr;
        float ss = 0.f;
#pragma unroll
        for (int ni = 0; ni < 4; ++ni) {
            f32x4 t = acc[mi][ni] * kkv[ni];
            ss += t[0] * t[0] + t[1] * t[1] + t[2] * t[2] + t[3] * t[3];
            st4bf(O + (size_t)row * 1024 + col0 + ni * 16 + fq * 4, acc[mi][ni]);
        }
        ss = xsum16_32(ss);
        if (fq == 0) KKN[(size_t)row * 16 + (col0 >> 6)] = rsqrtf(fmaxf(ss, 1e-24f));
    }
}

__device__ __forceinline__ void epi_readout(f32x4 (&acc)[4][4], int row0, int col0, int lane, const bf16_t* Y0, const bf16_t* Y1, const float* BS, const bf16_t* V,
                                            const float* lng, const float* lnb, bf16_t* Z) {
    const int fr = lane & 15, fq = lane >> 4, hd = col0 >> 6;
    f32x4 lg[4], lb[4];
#pragma unroll
    for (int ni = 0; ni < 4; ++ni) {
        lg[ni] = *(const f32x4*)(lng + col0 + ni * 16 + fq * 4);
        lb[ni] = *(const f32x4*)(lnb + col0 + ni * 16 + fq * 4);
    }
#pragma unroll
    for (int mi = 0; mi < 4; ++mi) {
        const int row = row0 + mi * 16 + fr, b = row / PB, pp = row - b * PB;
        const size_t li = (size_t)b * SEQL + (pp - CTXL);
        f32x4 wk[4];
        float s = 0.f;
#pragma unroll
        for (int ni = 0; ni < 4; ++ni) {
            const int col = col0 + ni * 16 + fq * 4;
            wk[ni] = ld4bf(Y0 + li * 1024 + col) + ld4bf(Y1 + li * 1024 + col);
            s += wk[ni][0] + wk[ni][1] + wk[ni][2] + wk[ni][3];
        }
        s = xsum16_32(s);
        const float mu = s * (1.0f / 64.0f);
        float q = 0.f;
#pragma unroll
        for (int ni = 0; ni < 4; ++ni) {
            wk[ni] = wk[ni] - mu;
            q += wk[ni][0] * wk[ni][0] + wk[ni][1] * wk[ni][1] + wk[ni][2] * wk[ni][2] + wk[ni][3] * wk[ni][3];
        }
        q = xsum16_32(q);
        const float rstd = rsqrtf(q * (1.0f / 64.0f) + 64e-5f);
        const float bsv = BS[(size_t)row * 16 + hd] + BS[(size_t)RT * 16 + (size_t)row * 16 + hd];
#pragma unroll
        for (int ni = 0; ni < 4; ++ni) {
            const int col = col0 + ni * 16 + fq * 4;
            f32x4 vv = ld4bf(V + (size_t)row * 1024 + col);
            f32x4 z = ((wk[ni] * rstd) * lg[ni] + lb[ni] + vv * bsv) * acc[mi][ni];
            st4bf(Z + (size_t)row * 1024 + col, z);
        }
    }
}

__device__ void attn_phase(const bf16_t* Q, const bf16_t* Kx, const bf16_t* VT, bf16_t* O, char* smem) {
    const int tid = threadIdx.x, lane = tid & 63, w = tid >> 6, fr = lane & 15, fq = lane >> 4;
    bf16_t* Ks = (bf16_t*)smem;
    bf16_t* Vs = Ks + 2 * 64 * 72;
    const int xcd = blockIdx.x & 7, slot = blockIdx.x >> 3, nslots = gridDim.x >> 3;
    const float cexp = 0.125f * 1.44269504088896f;
    const int lrow = tid >> 3, lch = (tid & 7) * 8;
    for (int it = slot; it < 528; it += nslots) {
        int pr, g, qb;
        if (it < 512) { pr = it >> 7; g = (it >> 5) & 3; qb = 1 + (it & 31); }
        else { const int li = it - 512; pr = li >> 2; g = li & 3; qb = 0; }
        const int pair = xcd + 8 * pr, b = pair >> 2, kvh = pair & 3, hq = kvh * 4 + g;
        const int nt = (qb == 0 ? CTXL : PB) >> 6;
        const int rowbase = b * PB + qb * 256 + w * 32;
        bf16x8 qf[2][2];
#pragma unroll
        for (int qt = 0; qt < 2; ++qt)
#pragma unroll
            for (int ks = 0; ks < 2; ++ks) qf[qt][ks] = *(const bf16x8*)(Q + (size_t)(rowbase + qt * 16 + fr) * 1024 + hq * 64 + ks * 32 + fq * 8);
        const bf16_t* kp = Kx + (size_t)(b * PB + lrow) * 256 + kvh * 64 + lch;
        const bf16_t* vp = VT + ((size_t)(b * 4 + kvh) * 64 + lrow) * PB + lch;
        f32x4 Oa[4][2];
#pragma unroll
        for (int dt = 0; dt < 4; ++dt)
#pragma unroll
            for (int qt = 0; qt < 2; ++qt) Oa[dt][qt] = (f32x4){0.f, 0.f, 0.f, 0.f};
        float mrun[2] = {-1e30f, -1e30f}, lrun[2] = {0.f, 0.f};
        uint4 rk = *(const uint4*)kp, rv = *(const uint4*)vp;
        __syncthreads();
        *(uint4*)(Ks + lrow * 72 + lch) = rk;
        *(uint4*)(Vs + lrow * 72 + lch) = rv;
        __syncthreads();
        for (int t = 0; t < nt; ++t) {
            const int cur = t & 1;
            if (t + 1 < nt) {
                rk = *(const uint4*)(kp + (size_t)(t + 1) * 64 * 256);
                rv = *(const uint4*)(vp + (t + 1) * 64);
            }
            const bf16_t* Kb = Ks + cur * 64 * 72;
            const bf16_t* Vb = Vs + cur * 64 * 72;
            f32x4 S[2][4];
#pragma unroll
            for (int kt = 0; kt < 4; ++kt) {
                bf16x8 k0 = *(const bf16x8*)(Kb + (kt * 16 + fr) * 72 + fq * 8), k1 = *(const bf16x8*)(Kb + (kt * 16 + fr) * 72 + 32 + fq * 8);
#pragma unroll
                for (int qt = 0; qt < 2; ++qt) {
                    f32x4 z = (f32x4){0.f, 0.f, 0.f, 0.f};
                    z = __builtin_amdgcn_mfma_f32_16x16x32_bf16(k0, qf[qt][0], z, 0, 0, 0);
                    S[qt][kt] = __builtin_amdgcn_mfma_f32_16x16x32_bf16(k1, qf[qt][1], z, 0, 0, 0);
                }
            }
            bf16x8 pf[2][2];
#pragma unroll
            for (int qt = 0; qt < 2; ++qt) {
                float mx = -1e30f;
#pragma unroll
                for (int kt = 0; kt < 4; ++kt)
#pragma unroll
                    for (int j = 0; j < 4; ++j) mx = fmaxf(mx, S[qt][kt][j]);
                mx = xmax16_32(mx);
                const float mnew = fmaxf(mrun[qt], mx);
                const float alpha = __builtin_amdgcn_exp2f((mrun[qt] - mnew) * cexp);
                mrun[qt] = mnew;
                const float mc = mnew * cexp;
                float rs = 0.f;
#pragma unroll
                for (int kt = 0; kt < 4; ++kt)
#pragma unroll
                    for (int j = 0; j < 4; ++j) {
                        float pv = __builtin_amdgcn_exp2f(S[qt][kt][j] * cexp - mc);
                        S[qt][kt][j] = pv;
                        rs += pv;
                    }
                lrun[qt] = lrun[qt] * alpha + rs;
#pragma unroll
                for (int dt = 0; dt < 4; ++dt) Oa[dt][qt] = Oa[dt][qt] * alpha;
#pragma unroll
                for (int s2 = 0; s2 < 2; ++s2) {
                    uint4 u;
                    u.x = pk2(S[qt][2 * s2][0], S[qt][2 * s2][1]);
                    u.y = pk2(S[qt][2 * s2][2], S[qt][2 * s2][3]);
                    u.z = pk2(S[qt][2 * s2 + 1][0], S[qt][2 * s2 + 1][1]);
                    u.w = pk2(S[qt][2 * s2 + 1][2], S[qt][2 * s2 + 1][3]);
                    pf[qt][s2] = __builtin_bit_cast(bf16x8, u);
                }
            }
#pragma unroll
            for (int dt = 0; dt < 4; ++dt)
#pragma unroll
                for (int s2 = 0; s2 < 2; ++s2) {
                    uint2 v0 = *(const uint2*)(Vb + (dt * 16 + fr) * 72 + s2 * 32 + fq * 4), v1 = *(const uint2*)(Vb + (dt * 16 + fr) * 72 + s2 * 32 + 16 + fq * 4);
                    uint4 u = make_uint4(v0.x, v0.y, v1.x, v1.y);
                    bf16x8 vf = __builtin_bit_cast(bf16x8, u);
#pragma unroll
                    for (int qt = 0; qt < 2; ++qt) Oa[dt][qt] = __builtin_amdgcn_mfma_f32_16x16x32_bf16(vf, pf[qt][s2], Oa[dt][qt], 0, 0, 0);
                }
            if (t + 1 < nt) {
                *(uint4*)(Ks + (cur ^ 1) * 64 * 72 + lrow * 72 + lch) = rk;
                *(uint4*)(Vs + (cur ^ 1) * 64 * 72 + lrow * 72 + lch) = rv;
            }
            __syncthreads();
        }
#pragma unroll
        for (int qt = 0; qt < 2; ++qt) {
            const float inv = 1.0f / xsum16_32(lrun[qt]);
            bf16_t* op = O + (size_t)(rowbase + qt * 16 + fr) * 1024 + hq * 64 + fq * 4;
#pragma unroll
            for (int dt = 0; dt < 4; ++dt) {
                f32x4 ov = Oa[dt][qt] * inv;
#ifdef DBG_CLAMPO
                for (int j = 0; j < 4; ++j) ov[j] = fminf(fmaxf(ov[j], -8.f), 8.f);
#endif
                st4bf(op + dt * 16, ov);
            }
        }
    }
}

#define DPPB(J) " row_newbcast:" #J " row_mask:0xf bank_mask:0xf bound_ctrl:1"
#define FMAC_BC(ACC, X, Y, J) asm("v_fmac_f32_dpp %0, %1, %2" DPPB(J) : "+v"(ACC) : "v"(X), "v"(Y))
#define MUL_BC(D, X, Y, J) asm("v_mul_f32_dpp %0, %1, %2" DPPB(J) : "=v"(D) : "v"(X), "v"(Y))
#define SCAN_J(J)                                  \
    MUL_BC(S[J], wv, S[J], J);                     \
    FMAC_BC(S[J], bv, sa, J);                      \
    FMAC_BC(S[J], kdv, vv, J);
#define SA_J(A, J) FMAC_BC(A, kkv, S[J], J);
#define Y_J(A, J) FMAC_BC(A, rv, S[J], J);

__device__ void scan_phase(const Pm& p, char* smem) {
    const int tid = threadIdx.x, lane = tid & 63, w = tid >> 6, fr = lane & 15, fq = lane >> 4;
    char* ws = p.ws;
    float* cb = (float*)smem;
    float* yp = cb + 2 * 6144;
    float* bp = yp + 2 * 4096;
    const bf16_t* Rr = (const bf16_t*)(ws + A1_R);
    const bf16_t* Kk = (const bf16_t*)(ws + A1_K);
    const bf16_t* Vv = (const bf16_t*)(ws + A1_V);
    const bf16_t* TW = (const bf16_t*)(ws + A1_TW);
    const bf16_t* TA = (const bf16_t*)(ws + A1_TA);
    const float* KKN = (const float*)(ws + OFF_KKN);
    const int NCH = PB / 16;
    for (int item = blockIdx.x; item < 256; item += gridDim.x) {
        const int b = item >> 5, dir = (item >> 4) & 1, h = item & 15;
        bf16_t* Y = (bf16_t*)(ws + (dir ? A1_Y1 : A1_Y0));
        float* BS = (float*)(ws + OFF_BS) + (size_t)dir * RT * 16;
        __syncthreads();
        if (w >= 4) {
            const int pw = w - 4, ch = h * 64 + pw * 16 + fq * 4;
            bf16x8 w2f[2], a2f[2];
#pragma unroll
            for (int ks = 0; ks < 2; ++ks) {
                w2f[ks] = *(const bf16x8*)((const bf16_t*)(ws + OFF_W2T) + ((size_t)dir * 1024 + h * 64 + pw * 16 + fr) * 64 + ks * 32 + fq * 8);
                a2f[ks] = *(const bf16x8*)((const bf16_t*)(ws + OFF_A2T) + ((size_t)dir * 1024 + h * 64 + pw * 16 + fr) * 64 + ks * 32 + fq * 8);
            }
            const f32x4 w0v = *(const f32x4*)(p.w0 + dir * 1024 + ch), a0v = *(const f32x4*)(p.a0 + dir * 1024 + ch);
            const f32x4 kkc = *(const f32x4*)(p.k_k + ch), kac = *(const f32x4*)(p.k_a + ch), rkc = *(const f32x4*)(p.r_k + ch);
            const int pt = tid - 256;
            for (int c = -1; c < NCH; ++c) {
                if (c + 1 < NCH) {
                    const int buf = (c + 1) & 1, n = (c + 1) * 16 + fr;
                    const int pp = n < CTXL ? (dir ? CTXL - 1 - n : n) : (dir ? (PB + CTXL - 1) - n : n);
                    const size_t row = (size_t)b * PB + pp;
                    f32x4 wp = (f32x4){0.f, 0.f, 0.f, 0.f}, ap = (f32x4){0.f, 0.f, 0.f, 0.f};
#pragma unroll
                    for (int ks = 0; ks < 2; ++ks) {
                        bf16x8 tw = *(const bf16x8*)(TW + row * 128 + dir * 64 + ks * 32 + fq * 8);
                        bf16x8 ta = *(const bf16x8*)(TA + row * 128 + dir * 64 + ks * 32 + fq * 8);
                        wp = __builtin_amdgcn_mfma_f32_16x16x32_bf16(w2f[ks], tw, wp, 0, 0, 0);
                        ap = __builtin_amdgcn_mfma_f32_16x16x32_bf16(a2f[ks], ta, ap, 0, 0, 0);
                    }
                    const f32x4 k4 = ld4bf(Kk + row * 1024 + ch), v4 = ld4bf(Vv + row * 1024 + ch), r4 = ld4bf(Rr + row * 1024 + ch);
                    const float kn = KKN[row * 16 + h];
                    f32x4 dec, kk4, b4, kd4;
                    float bsum = 0.f;
#pragma unroll
                    for (int j = 0; j < 4; ++j) {
                        const float z = -(w0v[j] + wp[j]);
                        const float sp = fmaxf(z, 0.f) + __logf(1.0f + __expf(-fabsf(z)));
                        const float wl = -sp - 0.5f;
                        dec[j] = __expf(-__expf(wl));
                        const float a = fsigmoid(a0v[j] + ap[j]);
                        kd4[j] = k4[j] * (1.0f + (a - 1.0f) * kac[j]);
                        kk4[j] = k4[j] * kkc[j] * kn;
                        b4[j] = kk4[j] * a;
                        bsum += r4[j] * kd4[j] * rkc[j];
                    }
                    float* cbb = cb + buf * 6144 + fr * 64 + pw * 16 + fq * 4;
                    *(f32x4*)(cbb + 0 * 1024) = dec;
                    *(f32x4*)(cbb + 1 * 1024) = kk4;
                    *(f32x4*)(cbb + 2 * 1024) = b4;
                    *(f32x4*)(cbb + 3 * 1024) = kd4;
                    *(f32x4*)(cbb + 4 * 1024) = r4;
                    *(f32x4*)(cbb + 5 * 1024) = v4;
                    bsum = xsum16_32(bsum);
                    if (fq == 0) bp[((c + 1) & 3) * 64 + fr * 4 + pw] = bsum;
                }
                if (c >= 1 && (c - 1) * 16 >= CTXL) {
                    const int co = c - 1, buf = co & 1;
                    const int tt = pt >> 4, vq = (pt & 15) * 4, n = co * 16 + tt;
                    const int pp = dir ? (PB + CTXL - 1) - n : n;
                    const float* ypb = yp + buf * 4096 + tt * 256 + vq;
                    f32x4 ys = *(const f32x4*)(ypb) + *(const f32x4*)(ypb + 64) + *(const f32x4*)(ypb + 128) + *(const f32x4*)(ypb + 192);
                    st4bf(Y + ((size_t)b * SEQL + (pp - CTXL)) * 1024 + h * 64 + vq, ys);
                    if ((pt & 15) == 0) {
                        const float* bb = bp + (co & 3) * 64 + tt * 4;
                        BS[((size_t)b * PB + pp) * 16 + h] = bb[0] + bb[1] + bb[2] + bb[3];
                    }
                }
                __syncthreads();
            }
            {
                const int co = NCH - 1, buf = co & 1;
                const int tt = pt >> 4, vq = (pt & 15) * 4, n = co * 16 + tt;
                const int pp = dir ? (PB + CTXL - 1) - n : n;
                const float* ypb = yp + buf * 4096 + tt * 256 + vq;
                f32x4 ys = *(const f32x4*)(ypb) + *(const f32x4*)(ypb + 64) + *(const f32x4*)(ypb + 128) + *(const f32x4*)(ypb + 192);
                st4bf(Y + ((size_t)b * SEQL + (pp - CTXL)) * 1024 + h * 64 + vq, ys);
                if ((pt & 15) == 0) {
                    const float* bb = bp + (co & 3) * 64 + tt * 4;
                    BS[((size_t)b * PB + pp) * 16 + h] = bb[0] + bb[1] + bb[2] + bb[3];
                }
            }
        } else {
            float S[16];
#pragma unroll
            for (int j = 0; j < 16; ++j) S[j] = 0.f;
            __syncthreads();
            for (int c = 0; c < NCH; ++c) {
                const float* cbb = cb + (c & 1) * 6144;
                float* ypb = yp + (c & 1) * 4096;
#pragma unroll 2
                for (int tt = 0; tt < 16; ++tt) {
                    const float wv = cbb[0 * 1024 + tt * 64 + lane], kkv = cbb[1 * 1024 + tt * 64 + lane], bv = cbb[2 * 1024 + tt * 64 + lane],
                                kdv = cbb[3 * 1024 + tt * 64 + lane], rv = cbb[4 * 1024 + tt * 64 + lane];
                    const float vv = cbb[5 * 1024 + tt * 64 + w * 16 + fr];
                    float s0 = 0.f, s1 = 0.f, s2 = 0.f, s3 = 0.f;
                    SA_J(s0, 0) SA_J(s1, 1) SA_J(s2, 2) SA_J(s3, 3) SA_J(s0, 4) SA_J(s1, 5) SA_J(s2, 6) SA_J(s3, 7)
                    SA_J(s0, 8) SA_J(s1, 9) SA_J(s2, 10) SA_J(s3, 11) SA_J(s0, 12) SA_J(s1, 13) SA_J(s2, 14) SA_J(s3, 15)
                    const float sa = -xsum16_32((s0 + s1) + (s2 + s3));
                    SCAN_J(0) SCAN_J(1) SCAN_J(2) SCAN_J(3) SCAN_J(4) SCAN_J(5) SCAN_J(6) SCAN_J(7)
                    SCAN_J(8) SCAN_J(9) SCAN_J(10) SCAN_J(11) SCAN_J(12) SCAN_J(13) SCAN_J(14) SCAN_J(15)
                    float y0 = 0.f, y1 = 0.f, y2 = 0.f, y3 = 0.f;
                    Y_J(y0, 0) Y_J(y1, 1) Y_J(y2, 2) Y_J(y3, 3) Y_J(y0, 4) Y_J(y1, 5) Y_J(y2, 6) Y_J(y3, 7)
                    Y_J(y0, 8) Y_J(y1, 9) Y_J(y2, 10) Y_J(y3, 11) Y_J(y0, 12) Y_J(y1, 13) Y_J(y2, 14) Y_J(y3, 15)
                    ypb[tt * 256 + fq * 64 + w * 16 + fr] = (y0 + y1) + (y2 + y3);
                }
                __syncthreads();
            }
        }
        __syncthreads();
    }
}

#define NPHASE 17
#ifndef PH_MASK
#define PH_MASK 0x1ffff
#endif
#define PHON(n) ((PH_MASK >> (n)) & 1)
#ifndef DBG_ZMASK
#define DBG_ZMASK 0
#endif
template <int PH> __device__ __forceinline__ void run_phase(const Pm& p, char* smem) {
    char* ws = p.ws;
    const int G = gridDim.x, wv = threadIdx.x >> 6, lane = threadIdx.x & 63;
    const int wr = wv >> 1, wc = wv & 1;
    const float* MOD0 = (const float*)(ws + OFF_MOD);
    const float* MOD1 = MOD0 + 9 * 6144;
    float* XC = (float*)(ws + OFF_XC);
    {
        switch (PH) {
        case 0: if (!PHON(0)) break; phase0(p, smem); break;
        case 1: if (!PHON(1)) break; norm_phase<0>(p.x, p.ctx, p.n1g, MOD0, 0, 1, (bf16_t*)(ws + A0_H), nullptr, false); break;
        case 2: if (!PHON(2)) break; {
            GemmArgs ga{(const bf16_t*)(ws + A0_H), nullptr, nullptr, (const bf16_t*)(ws + OFF_WQKV), 1024, 1024};
            for (int t = blockIdx.x; t < 264 * 12; t += G) {
                const int tm = t / 12, tn = t - tm * 12;
                f32x4 acc[4][4];
                gemm_main<0>(ga, tm, tn, acc, smem);
                epi_qkv(acc, tm * 256 + wr * 64, tn * 128 + wc * 64, lane, (bf16_t*)(ws + A0_Q), (bf16_t*)(ws + A0_K), (bf16_t*)(ws + A0_VT), p.qg, p.kg,
                        (const float*)(ws + OFF_ROPE));
            }
        } break;
        case 3: if (!PHON(3)) break; attn_phase((const bf16_t*)(ws + A0_Q), (const bf16_t*)(ws + A0_K), (const bf16_t*)(ws + A0_VT), (bf16_t*)(ws + A0_O), smem); break;
        case 4: if (!PHON(4)) break; {
            GemmArgs ga{(const bf16_t*)(ws + A0_O), nullptr, nullptr, (const bf16_t*)(ws + OFF_AWO), 1024, 1024};
            for (int t = blockIdx.x; t < 264 * 8; t += G) {
                const int tm = t >> 3, tn = t & 7;
                f32x4 acc[4][4];
                gemm_main<0>(ga, tm, tn, acc, smem);
                epi_res(acc, tm * 256 + wr * 64, tn * 128 + wc * 64, lane, p.x, p.ctx, p.out, XC, MOD0, 2, (DBG_ZMASK & 1) ? 0.f : 1.f);
            }
        } break;
        case 5: if (!PHON(5)) break; norm_phase<0>(p.out, XC, p.n2g, MOD0, 3, 4, (bf16_t*)(ws + A0_H), nullptr, false); break;
        case 6: if (!PHON(6)) break; {
            GemmArgs ga{(const bf16_t*)(ws + A0_H), nullptr, nullptr, (const bf16_t*)(ws + OFF_GU), 1024, 1024};
            for (int t = blockIdx.x; t < 264 * 44; t += G) {
                const int tm = t / 44, tn = t - tm * 44;
                f32x4 acc[4][4];
                gemm_main<0>(ga, tm, tn, acc, smem);
                epi_swiglu(acc, tm * 256 + wr * 64, tn * 128 + wc * 64, lane, (bf16_t*)(ws + A0_ACT));
            }
        } break;
        case 7: if (!PHON(7)) break; {
            GemmArgs ga{(const bf16_t*)(ws + A0_ACT), nullptr, nullptr, (const bf16_t*)(ws + OFF_WD), DFF, DFF};
            for (int t = blockIdx.x; t < 264 * 8; t += G) {
                const int tm = t >> 3, tn = t & 7;
                f32x4 acc[4][4];
                gemm_main<0>(ga, tm, tn, acc, smem);
                epi_res(acc, tm * 256 + wr * 64, tn * 128 + wc * 64, lane, p.out, XC, p.out, XC, MOD0, 5, (DBG_ZMASK & 2) ? 0.f : 1.f);
            }
        } break;
        case 8: if (!PHON(8)) break; norm_phase<1>(p.out, XC, p.n1g + 1024, MOD1, 0, 1, (bf16_t*)(ws + A1_H), (bf16_t*)(ws + A1_XX), false); break;
        case 9: if (!PHON(9)) break; {
            for (int t = blockIdx.x; t < 264 * 27; t += G) {
                const int tm = t / 27, r = t - tm * 27;
                int jobi, tn;
                if (r < 24) { jobi = r >> 3; tn = r & 7; } else { jobi = r - 21; tn = 0; }
                const int mixrow = jobi == 0 ? 0 : jobi == 1 ? 2 : jobi == 2 ? 3 : jobi == 3 ? 1 : jobi == 4 ? 4 : 5;
                const bf16_t* Bt = jobi < 3 ? (const bf16_t*)(ws + OFF_WRKV) + (size_t)jobi * 1024 * 1024
                                            : (const bf16_t*)(ws + (jobi == 3 ? OFF_W1T : jobi == 4 ? OFF_A1T : OFF_G1T));
                GemmArgs ga{(const bf16_t*)(ws + A1_H), (const bf16_t*)(ws + A1_XX), p.mix + mixrow * 1024, Bt, 1024, 1024};
                f32x4 acc[4][4];
                gemm_main<1>(ga, tm, tn, acc, smem);
                const int row0 = tm * 256 + wr * 64, col0 = tn * 128 + wc * 64;
                switch (jobi) {
                case 0: epi_store<0>(acc, row0, col0, lane, (bf16_t*)(ws + A1_R), 1024); break;
                case 1: epi_kstore(acc, row0, col0, lane, (bf16_t*)(ws + A1_K), p.k_k, (float*)(ws + OFF_KKN)); break;
                case 2: epi_store<0>(acc, row0, col0, lane, (bf16_t*)(ws + A1_V), 1024); break;
                case 3: epi_store<1>(acc, row0, col0, lane, (bf16_t*)(ws + A1_TW), 128); break;
                case 4: epi_store<0>(acc, row0, col0, lane, (bf16_t*)(ws + A1_TA), 128); break;
                default: epi_store<2>(acc, row0, col0, lane, (bf16_t*)(ws + A1_GH), 128); break;
                }
            }
        } break;
        case 10: if (!PHON(10)) break; scan_phase(p, smem); break;
        case 11: if (!PHON(11)) break; {
            GemmArgs ga{(const bf16_t*)(ws + A1_GH), nullptr, nullptr, (const bf16_t*)(ws + OFF_G2T), 128, 128};
            for (int t = blockIdx.x; t < 264 * 8; t += G) {
                const int tm = t >> 3, tn = t & 7;
                if (tm % 33 == 0) continue;
                f32x4 acc[4][4];
                gemm_main<0>(ga, tm, tn, acc, smem);
                epi_readout(acc, tm * 256 + wr * 64, tn * 128 + wc * 64, lane, (const bf16_t*)(ws + A1_Y0), (const bf16_t*)(ws + A1_Y1),
                            (const float*)(ws + OFF_BS), (const bf16_t*)(ws + A1_V), p.lng, p.lnb, (bf16_t*)(ws + A1_Z));
            }
        } break;
        case 12: if (!PHON(12)) break; {
            GemmArgs ga{(const bf16_t*)(ws + A1_Z), nullptr, nullptr, (const bf16_t*)(ws + OFF_RWO), 1024, 1024};
            for (int t = blockIdx.x; t < 264 * 8; t += G) {
                const int tm = t >> 3, tn = t & 7;
                if (tm % 33 == 0) continue;
                f32x4 acc[4][4];
                gemm_main<0>(ga, tm, tn, acc, smem);
                epi_res(acc, tm * 256 + wr * 64, tn * 128 + wc * 64, lane, p.out, XC, p.out, XC, MOD1, 2, (DBG_ZMASK & 4) ? 0.f : 1.f);
            }
        } break;
        case 13: if (!PHON(13)) break; norm_phase<0>(p.out, XC, p.n2g + 1024, MOD1, 3, 4, (bf16_t*)(ws + A1_H2), nullptr, true); break;
        case 14: if (!PHON(14)) break; {
            GemmArgs ga{(const bf16_t*)(ws + A1_H2), nullptr, nullptr, (const bf16_t*)(ws + OFF_GU) + (size_t)5632 * 1024, 1024, 1024};
            for (int t = blockIdx.x; t < 264 * 44; t += G) {
                const int tm = t / 44, tn = t - tm * 44;
                if (tm % 33 == 0) continue;
                f32x4 acc[4][4];
                gemm_main<0>(ga, tm, tn, acc, smem);
                epi_swiglu(acc, tm * 256 + wr * 64, tn * 128 + wc * 64, lane, (bf16_t*)(ws + A1_ACT));
            }
        } break;
        case 15: if (!PHON(15)) break; {
            GemmArgs ga{(const bf16_t*)(ws + A1_ACT), nullptr, nullptr, (const bf16_t*)(ws + OFF_WD) + (size_t)1024 * DFF, DFF, DFF};
            for (int t = blockIdx.x; t < 264 * 8; t += G) {
                const int tm = t >> 3, tn = t & 7;
                if (tm % 33 == 0) continue;
                f32x4 acc[4][4];
                gemm_main<0>(ga, tm, tn, acc, smem);
                epi_res(acc, tm * 256 + wr * 64, tn * 128 + wc * 64, lane, p.out, XC, p.out, XC, MOD1, 5, (DBG_ZMASK & 8) ? 0.f : 1.f);
            }
        } break;
        case 16: if (!PHON(16)) break; final_norm_phase(p.out, p.fg); break;
        default: break;
        }
    }
}

#define DO_PHASE(n)                                  \
    if (p.plo <= (n) && (n) < p.phi) {               \
        if ((n) > p.plo) grid.sync();                \
        run_phase<n>(p, smem);                       \
    }
__global__ void __launch_bounds__(NTHR) fwd_kernel(Pm p) {
    extern __shared__ __attribute__((aligned(16))) char smem[];
    cg::grid_group grid = cg::this_grid();
    DO_PHASE(0) DO_PHASE(1) DO_PHASE(2) DO_PHASE(3) DO_PHASE(4) DO_PHASE(5) DO_PHASE(6) DO_PHASE(7) DO_PHASE(8)
    DO_PHASE(9) DO_PHASE(10) DO_PHASE(11) DO_PHASE(12) DO_PHASE(13) DO_PHASE(14) DO_PHASE(15) DO_PHASE(16)
}

extern "C" void kernel_launch(void* const* d_in, const int* in_sizes, int n_in, void* d_out, int out_size, void* d_ws, size_t ws_size, hipStream_t stream) {
    Pm p{};
    const float** pp = (const float**)&p;
    for (int i = 0; i < 32; ++i) pp[i] = (const float*)d_in[i];
    p.out = (float*)d_out;
    p.ws = (char*)d_ws;
    if (ws_size < WS_NEED) fprintf(stderr, "workspace too small: %zu < %zu\n", ws_size, (size_t)WS_NEED);
    static int grid_blocks = 0;
    if (!grid_blocks) {
        hipFuncSetAttribute((const void*)fwd_kernel, hipFuncAttributeMaxDynamicSharedMemorySize, LDS_BYTES);
        int dev = 0, cus = 0, per_cu = 0;
        hipGetDevice(&dev);
        hipDeviceGetAttribute(&cus, hipDeviceAttributeMultiprocessorCount, dev);
        hipOccupancyMaxActiveBlocksPerMultiprocessor(&per_cu, fwd_kernel, NTHR, LDS_BYTES);
        if (per_cu < 1) per_cu = 1;
        grid_blocks = cus * per_cu;
    }
#if MULTI_LAUNCH
    for (int ph = 0; ph < NPHASE; ++ph) {
        p.plo = ph;
        p.phi = ph + 1;
        hipLaunchKernelGGL(fwd_kernel, dim3(grid_blocks), dim3(NTHR), LDS_BYTES, stream, p);
    }
#else
    p.plo = 0;
    p.phi = NPHASE;
    void* args[] = {&p};
    hipError_t e = hipLaunchCooperativeKernel((void*)fwd_kernel, dim3(grid_blocks), dim3(NTHR), args, LDS_BYTES, stream);
    if (e != hipSuccess) fprintf(stderr, "cooperative launch failed: %s (grid %d)\n", hipGetErrorString(e), grid_blocks);
#endif
}
```

```cpp
#include <hip/hip_runtime.h>
#include <hip/hip_cooperative_groups.h>
#include <cstdint>
#include <cstdio>
namespace cg = cooperative_groups;

#ifndef MULTI_LAUNCH
#define MULTI_LAUNCH 0
#endif

typedef unsigned short bf16_t;
typedef short bf16x8 __attribute__((ext_vector_type(8)));
typedef float f32x4 __attribute__((ext_vector_type(4)));

#define NB 8
#define SEQL 8192
#define CTXL 256
#define PB 8448
#define RT (NB * PB)
#define DM 1024
#define DFF 2816
#define NTHR 512

constexpr size_t U = (size_t)RT * 1024 * 2;
constexpr size_t OFF_WQKV = 0;
constexpr size_t OFF_AWO = OFF_WQKV + (size_t)1536 * 1024 * 2;
constexpr size_t OFF_GU = OFF_AWO + (size_t)1024 * 1024 * 2;
constexpr size_t OFF_WD = OFF_GU + (size_t)2 * 5632 * 1024 * 2;
constexpr size_t OFF_WRKV = OFF_WD + (size_t)2 * 1024 * 2816 * 2;
constexpr size_t OFF_W1T = OFF_WRKV + (size_t)3 * 1024 * 1024 * 2;
constexpr size_t OFF_A1T = OFF_W1T + (size_t)128 * 1024 * 2;
constexpr size_t OFF_G1T = OFF_A1T + (size_t)128 * 1024 * 2;
constexpr size_t OFF_W2T = OFF_G1T + (size_t)128 * 1024 * 2;
constexpr size_t OFF_A2T = OFF_W2T + (size_t)2 * 1024 * 64 * 2;
constexpr size_t OFF_G2T = OFF_A2T + (size_t)2 * 1024 * 64 * 2;
constexpr size_t OFF_RWO = OFF_G2T + (size_t)1024 * 128 * 2;
constexpr size_t OFF_MOD = OFF_RWO + (size_t)1024 * 1024 * 2;
constexpr size_t OFF_ROPE = OFF_MOD + (size_t)2 * 9 * 6144 * 4;
constexpr size_t OFF_KKN = OFF_ROPE + (size_t)2 * 128 * 16 * 4;
constexpr size_t OFF_BS = OFF_KKN + (size_t)RT * 16 * 4;
constexpr size_t OFF_XC = OFF_BS + (size_t)2 * RT * 16 * 4;
constexpr size_t OFF_ACTR = OFF_XC + (size_t)NB * CTXL * DM * 4;
constexpr size_t A0_H = OFF_ACTR, A0_Q = A0_H + U, A0_K = A0_Q + U, A0_VT = A0_K + U / 4, A0_O = A0_VT + U / 4, A0_ACT = A0_O + U;
constexpr size_t A1_H = OFF_ACTR, A1_XX = A1_H + U, A1_R = A1_XX + U, A1_K = A1_R + U, A1_V = A1_K + U, A1_TW = A1_V + U, A1_TA = A1_TW + U / 8,
                 A1_GH = A1_TA + U / 8;
constexpr size_t A1_Y0 = OFF_ACTR, A1_Y1 = OFF_ACTR + U, A1_Z = A1_R, A1_H2 = OFF_ACTR, A1_ACT = A1_K;
constexpr size_t WS_NEED = A0_ACT + (size_t)RT * DFF * 2;

constexpr size_t OFF_SYNC = WS_NEED;
constexpr int LDS_BYTES = 2 * (256 + 256) * 72 * 2;

struct Pm {
    const float *x, *c, *ctx, *c_ctx, *mod_w, *mod_b, *n1g, *n2g, *wg, *wu, *wd, *wqkv, *qg, *kg, *awo, *mix, *wrkv, *w0, *w1, *w2, *a0, *a1, *a2, *g1,
        *g2, *k_k, *k_a, *r_k, *lng, *lnb, *rwo, *fg;
    float* out;
    char* ws;
    int plo, phi;
};

typedef __bf16 bf16v2_t __attribute__((ext_vector_type(2)));
typedef float f32v2_t __attribute__((ext_vector_type(2)));
__device__ __forceinline__ unsigned pk2(float lo, float hi) {
    f32v2_t f = {lo, hi};
    bf16v2_t v = __builtin_convertvector(f, bf16v2_t);
    return __builtin_bit_cast(unsigned, v);
}
__device__ __forceinline__ bf16_t f2bf(float f) { return (bf16_t)(pk2(f, 0.f) & 0xffffu); }
__device__ __forceinline__ float bflo(unsigned u) { return __uint_as_float(u << 16); }
__device__ __forceinline__ float bfhi(unsigned u) { return __uint_as_float(u & 0xffff0000u); }
__device__ __forceinline__ void st4bf(bf16_t* p, float a, float b, float c, float d) { *(uint2*)p = make_uint2(pk2(a, b), pk2(c, d)); }
__device__ __forceinline__ void st4bf(bf16_t* p, f32x4 v) { st4bf(p, v[0], v[1], v[2], v[3]); }
__device__ __forceinline__ f32x4 ld4bf(const bf16_t* p) {
    uint2 u = *(const uint2*)p;
    return (f32x4){bflo(u.x), bfhi(u.x), bflo(u.y), bfhi(u.y)};
}
__device__ __forceinline__ float xsum16_32(float v) {
    v += __shfl_xor(v, 16);
    v += __shfl_xor(v, 32);
    return v;
}
__device__ __forceinline__ float xmax16_32(float v) {
    v = fmaxf(v, __shfl_xor(v, 16));
    v = fmaxf(v, __shfl_xor(v, 32));
    return v;
}
__device__ __forceinline__ float wave_sum(float v) {
#pragma unroll
    for (int o = 32; o >= 1; o >>= 1) v += __shfl_xor(v, o);
    return v;
}
__device__ __forceinline__ float fsigmoid(float x) { return __builtin_amdgcn_rcpf(1.0f + __expf(-x)); }
__device__ __forceinline__ float fsilu(float x) { return x * __builtin_amdgcn_rcpf(1.0f + __expf(-x)); }
__device__ __forceinline__ float ftanh(float x) {
    float e = __expf(-2.0f * fabsf(x));
    float t = (1.0f - e) * __builtin_amdgcn_rcpf(1.0f + e);
    return x < 0.f ? -t : t;
}
template <class T> __device__ __forceinline__ T* xrow(T* lat, T* ctxp, int r) {
    int b = r / PB, p = r - b * PB;
    return p < CTXL ? ctxp + (size_t)(b * CTXL + p) * DM : lat + (size_t)(b * SEQL + (p - CTXL)) * DM;
}
__device__ __forceinline__ int modrow(int r) {
    int b = r / PB, p = r - b * PB;
    return p < CTXL ? 8 : b;
}

__device__ __forceinline__ void conv_tile(const float* src, bf16_t* dst, int K, int N, int mode, int roff, int t, float* tl) {
    const int tid = threadIdx.x;
    const int ntn = N >> 6;
    const int tk = t / ntn, tn = t - tk * ntn, k0 = tk * 64, n0 = tn * 64;
    __syncthreads();
#pragma unroll
    for (int i = 0; i < 8; ++i) {
        int k = (tid >> 6) + 8 * i;
        tl[k * 65 + (tid & 63)] = src[(size_t)(k0 + k) * N + n0 + (tid & 63)];
    }
    __syncthreads();
#pragma unroll
    for (int i = 0; i < 4; ++i) {
        int n = (tid >> 5) + 16 * i, ng = n0 + n, kp = (tid & 31) * 2;
        int drow = mode ? ((ng >> 4) * 32 + (ng & 15) + roff) : (ng + roff);
        *(unsigned*)(dst + (size_t)drow * K + k0 + kp) = pk2(tl[kp * 65 + n], tl[(kp + 1) * 65 + n]);
    }
}

__device__ void phase0(const Pm& p, char* smem) {
    const int tid = threadIdx.x, G = gridDim.x;
    char* ws = p.ws;
    float* fl = (float*)smem;
    if (blockIdx.x < 192) {
        float* s = fl;
        float* red = fl + 9 * 1024;
        for (int idx = tid; idx < 9 * 1024; idx += NTHR) {
            int r = idx >> 10, k = idx & 1023;
            float v = r < 8 ? p.c[r * 1024 + k] : p.c_ctx[k];
            s[idx] = fsilu(v);
        }
        __syncthreads();
        for (int it = blockIdx.x; it < 192; it += G) {
            const int l = it / 96, q = it - l * 96;
            const int col = q * 64 + (tid & 63), kg = tid >> 6;
            const float* wp = p.mod_w + (size_t)l * 1024 * 6144 + col;
            float acc[9];
#pragma unroll
            for (int r = 0; r < 9; ++r) acc[r] = 0.f;
#pragma unroll 8
            for (int kk = 0; kk < 128; ++kk) {
                int k = kg * 128 + kk;
                float w = wp[(size_t)k * 6144];
#pragma unroll
                for (int r = 0; r < 9; ++r) acc[r] += s[r * 1024 + k] * w;
            }
#pragma unroll
            for (int r = 0; r < 9; ++r) red[(kg * 9 + r) * 64 + (tid & 63)] = acc[r];
            __syncthreads();
            for (int idx = tid; idx < 9 * 64; idx += NTHR) {
                int r = idx >> 6, cc = idx & 63;
                float v = 0.f;
#pragma unroll
                for (int g8 = 0; g8 < 8; ++g8) v += red[(g8 * 9 + r) * 64 + cc];
                int cg_ = q * 64 + cc;
                ((float*)(ws + OFF_MOD))[((size_t)l * 9 + r) * 6144 + cg_] = v + p.mod_b[l * 6144 + cg_];
            }
            __syncthreads();
        }
    }
    if (blockIdx.x == G - 1) {
        float* rt = (float*)(ws + OFF_ROPE);
        for (int idx = tid; idx < 2048; idx += NTHR) {
            int pos = idx >> 4, pi = idx & 15;
            float inv = powf(10000.0f, -(float)pi / 16.0f);
            float ang = (float)pos * inv;
            rt[idx] = cosf(ang);
            rt[2048 + idx] = sinf(ang);
        }
    }
    int cur = blockIdx.x, base = 0;
    auto job = [&](const float* src, bf16_t* dst, int K, int N, int mode, int roff) {
        int n = (K >> 6) * (N >> 6);
        while (cur < base + n) {
            conv_tile(src, dst, K, N, mode, roff, cur - base, fl);
            cur += G;
        }
        base += n;
    };
    job(p.wqkv, (bf16_t*)(ws + OFF_WQKV), 1024, 1536, 0, 0);
    job(p.awo, (bf16_t*)(ws + OFF_AWO), 1024, 1024, 0, 0);
    for (int l = 0; l < 2; ++l) {
        job(p.wg + (size_t)l * 1024 * DFF, (bf16_t*)(ws + OFF_GU) + (size_t)l * 5632 * 1024, 1024, DFF, 1, 0);
        job(p.wu + (size_t)l * 1024 * DFF, (bf16_t*)(ws + OFF_GU) + (size_t)l * 5632 * 1024, 1024, DFF, 1, 16);
        job(p.wd + (size_t)l * DFF * 1024, (bf16_t*)(ws + OFF_WD) + (size_t)l * 1024 * DFF, DFF, 1024, 0, 0);
    }
    for (int j = 0; j < 3; ++j) job(p.wrkv + (size_t)j * 1024 * 1024, (bf16_t*)(ws + OFF_WRKV) + (size_t)j * 1024 * 1024, 1024, 1024, 0, 0);
    for (int d = 0; d < 2; ++d) {
        job(p.w1 + (size_t)d * 1024 * 64, (bf16_t*)(ws + OFF_W1T), 1024, 64, 0, d * 64);
        job(p.a1 + (size_t)d * 1024 * 64, (bf16_t*)(ws + OFF_A1T), 1024, 64, 0, d * 64);
        job(p.w2 + (size_t)d * 64 * 1024, (bf16_t*)(ws + OFF_W2T) + (size_t)d * 1024 * 64, 64, 1024, 0, 0);
        job(p.a2 + (size_t)d * 64 * 1024, (bf16_t*)(ws + OFF_A2T) + (size_t)d * 1024 * 64, 64, 1024, 0, 0);
    }
    job(p.g1, (bf16_t*)(ws + OFF_G1T), 1024, 128, 0, 0);
    job(p.g2, (bf16_t*)(ws + OFF_G2T), 128, 1024, 0, 0);
    job(p.rwo, (bf16_t*)(ws + OFF_RWO), 1024, 1024, 0, 0);
}

__device__ __forceinline__ void norm_row(const float* xr, const float* g, const float* msh, const float* msc, f32x4 (&h)[4], int lane) {
    f32x4 v[4];
    float ss = 0.f;
#pragma unroll
    for (int i = 0; i < 4; ++i) {
        v[i] = *(const f32x4*)(xr + lane * 4 + i * 256);
        ss += v[i][0] * v[i][0] + v[i][1] * v[i][1] + v[i][2] * v[i][2] + v[i][3] * v[i][3];
    }
    ss = wave_sum(ss);
    const float rstd = rsqrtf(ss * (1.0f / 1024.0f) + 1e-6f);
#pragma unroll
    for (int i = 0; i < 4; ++i) {
        f32x4 gg = *(const f32x4*)(g + lane * 4 + i * 256);
        f32x4 sh = *(const f32x4*)(msh + lane * 4 + i * 256);
        f32x4 sc = *(const f32x4*)(msc + lane * 4 + i * 256);
        h[i] = (v[i] * rstd) * gg * (sc + 1.0f) + sh;
    }
}

template <int SHIFT>
__device__ void norm_phase(const float* lat, const float* ctxp, const float* g, const float* modl, int shI, int scI, bf16_t* H, bf16_t* XX, bool lat_only) {
    const int lane = threadIdx.x & 63, w = threadIdx.x >> 6;
    const int nw = gridDim.x * 8;
    if (SHIFT) {
        for (int grp = blockIdx.x * 8 + w; grp < RT / 4; grp += nw) {
            const int row0 = grp * 4, b = row0 / PB, pp0 = row0 - b * PB;
            const int mr = pp0 < CTXL ? 8 : b;
            const float* msh = modl + (size_t)mr * 6144 + shI * 1024;
            const float* msc = modl + (size_t)mr * 6144 + scI * 1024;
            const bool hasP = !(pp0 == 0 || pp0 == CTXL), hasN = !(pp0 + 3 == CTXL - 1 || pp0 + 3 == PB - 1);
            f32x4 hprev[4], hcur[4], hnext[4];
            if (hasP) norm_row(xrow(lat, ctxp, row0 - 1), g, msh, msc, hprev, lane);
            else {
#pragma unroll
                for (int i = 0; i < 4; ++i) hprev[i] = (f32x4){0.f, 0.f, 0.f, 0.f};
            }
            norm_row(xrow(lat, ctxp, row0), g, msh, msc, hcur, lane);
#pragma unroll
            for (int r = 0; r < 4; ++r) {
                const int row = row0 + r;
                if (r < 3 || hasN) norm_row(xrow(lat, ctxp, row + 1), g, msh, msc, hnext, lane);
                else {
#pragma unroll
                    for (int i = 0; i < 4; ++i) hnext[i] = (f32x4){0.f, 0.f, 0.f, 0.f};
                }
#pragma unroll
                for (int i = 0; i < 4; ++i) {
                    st4bf(H + (size_t)row * DM + lane * 4 + i * 256, hcur[i]);
                    st4bf(XX + (size_t)row * DM + lane * 4 + i * 256, (hprev[i] + hnext[i]) * 0.5f - hcur[i]);
                    hprev[i] = hcur[i];
                    hcur[i] = hnext[i];
                }
            }
        }
        return;
    }
    for (int row = blockIdx.x * 8 + w; row < RT; row += nw) {
        const int b = row / PB, pp = row - b * PB;
        if (lat_only && pp < CTXL) continue;
        const int mr = pp < CTXL ? 8 : b;
        const float* msh = modl + (size_t)mr * 6144 + shI * 1024;
        const float* msc = modl + (size_t)mr * 6144 + scI * 1024;
        f32x4 h[4];
        norm_row(xrow(lat, ctxp, row), g, msh, msc, h, lane);
#pragma unroll
        for (int i = 0; i < 4; ++i) st4bf(H + (size_t)row * DM + lane * 4 + i * 256, h[i]);
        if (SHIFT) {
            f32x4 hp[4], hn[4];
            const bool hasP = !(pp == 0 || pp == CTXL), hasN = !(pp == CTXL - 1 || pp == PB - 1);
            if (hasP) norm_row(xrow(lat, ctxp, row - 1), g, msh, msc, hp, lane);
            else {
#pragma unroll
                for (int i = 0; i < 4; ++i) hp[i] = (f32x4){0.f, 0.f, 0.f, 0.f};
            }
            if (hasN) norm_row(xrow(lat, ctxp, row + 1), g, msh, msc, hn, lane);
            else {
#pragma unroll
                for (int i = 0; i < 4; ++i) hn[i] = (f32x4){0.f, 0.f, 0.f, 0.f};
            }
#pragma unroll
            for (int i = 0; i < 4; ++i) st4bf(XX + (size_t)row * DM + lane * 4 + i * 256, (hp[i] + hn[i]) * 0.5f - h[i]);
        }
    }
}

__device__ void final_norm_phase(float* X, const float* g) {
    const int lane = threadIdx.x & 63, w = threadIdx.x >> 6;
    const int nw = gridDim.x * 8;
    for (int row = blockIdx.x * 8 + w; row < NB * SEQL; row += nw) {
        float* xr = X + (size_t)row * DM;
        f32x4 v[4];
        float ss = 0.f;
#pragma unroll
        for (int i = 0; i < 4; ++i) {
            v[i] = *(const f32x4*)(xr + lane * 4 + i * 256);
            ss += v[i][0] * v[i][0] + v[i][1] * v[i][1] + v[i][2] * v[i][2] + v[i][3] * v[i][3];
        }
        ss = wave_sum(ss);
        const float rstd = rsqrtf(ss * (1.0f / 1024.0f) + 1e-6f);
#pragma unroll
        for (int i = 0; i < 4; ++i) {
            f32x4 gg = *(const f32x4*)(g + lane * 4 + i * 256);
            *(f32x4*)(xr + lane * 4 + i * 256) = (v[i] * rstd) * gg;
        }
    }
}

struct GemmArgs {
    const bf16_t* A;
    const bf16_t* A2;
    const float* mix;
    const bf16_t* Bt;
    int K, lda;
};

template <int AMODE, int BN>
__device__ __forceinline__ void gemm_main(const GemmArgs g, int tm, int tn, f32x4 (&acc)[BN / 128][4][4], char* smem) {
    constexpr int MT = BN / 128;
    const bf16_t* const gA = g.A; const bf16_t* const gA2 = g.A2; const float* const gmix = g.mix; const bf16_t* const gBt = g.Bt; const int lda = g.lda;
    const int tid = threadIdx.x, lane = tid & 63, w = tid >> 6;
    const int wr = (BN == 256) ? (w >> 2) : (w >> 1), wc = (BN == 256) ? (w & 3) : (w & 1), fr = lane & 15, fq = lane >> 4;
    bf16_t* As = (bf16_t*)smem;
    bf16_t* Bs = As + 2 * 256 * 72;
    const int K = g.K, nk = K >> 6;
#pragma unroll
    for (int h = 0; h < MT; ++h)
#pragma unroll
        for (int mi = 0; mi < 4; ++mi)
#pragma unroll
            for (int ni = 0; ni < 4; ++ni) acc[h][mi][ni] = (f32x4){0.f, 0.f, 0.f, 0.f};
    uint4 ra0, ra1, ra2, ra3;
#define rb0 ra0
#define rb1 ra1
#define rb2 ra2
#define rb3 ra3
    const int arow = tid >> 3, akc = (tid & 7) * 8;
    const bf16_t* Ap = gA + (size_t)(tm * 256 + arow) * lda + akc;
    const bf16_t* A2p = AMODE ? gA2 + (size_t)(tm * 256 + arow) * lda + akc : nullptr;
    const bf16_t* Bp = gBt + (size_t)(tn * BN + arow) * K + akc;
#define GLOAD_A(R, I, KT)                                                                                         \
    {                                                                                                             \
        uint4 hv = *(const uint4*)(Ap + (size_t)(I) * 64 * lda + (KT) * 64);                                      \
        if (AMODE) {                                                                                              \
            uint4 xv = *(const uint4*)(A2p + (size_t)(I) * 64 * lda + (KT) * 64);                                 \
            f32x4 m0 = *(const f32x4*)(gmix + (KT) * 64 + akc), m1 = *(const f32x4*)(gmix + (KT) * 64 + akc + 4); \
            hv.x = pk2(bflo(hv.x) + bflo(xv.x) * m0[0], bfhi(hv.x) + bfhi(xv.x) * m0[1]);                         \
            hv.y = pk2(bflo(hv.y) + bflo(xv.y) * m0[2], bfhi(hv.y) + bfhi(xv.y) * m0[3]);                         \
            hv.z = pk2(bflo(hv.z) + bflo(xv.z) * m1[0], bfhi(hv.z) + bfhi(xv.z) * m1[1]);                         \
            hv.w = pk2(bflo(hv.w) + bflo(xv.w) * m1[2], bfhi(hv.w) + bfhi(xv.w) * m1[3]);                         \
        }                                                                                                         \
        R = hv;                                                                                                   \
    }
#define GLOAD_AALL(KT) GLOAD_A(ra0, 0, KT) GLOAD_A(ra1, 1, KT) GLOAD_A(ra2, 2, KT) GLOAD_A(ra3, 3, KT)
#define GLOAD_BALL(KT)                                                                \
    rb0 = *(const uint4*)(Bp + (KT) * 64);                                            \
    rb1 = *(const uint4*)(Bp + (size_t)64 * K + (KT) * 64);                           \
    if (BN == 256) {                                                                  \
        rb2 = *(const uint4*)(Bp + (size_t)128 * K + (KT) * 64);                      \
        rb3 = *(const uint4*)(Bp + (size_t)192 * K + (KT) * 64);                      \
    }
#define LSTORE_A(BUF)                                                                \
    {                                                                                \
        bf16_t* a_ = As + (size_t)(BUF) * 256 * 72 + arow * 72 + akc;                \
        *(uint4*)(a_) = ra0;                                                         \
        *(uint4*)(a_ + 64 * 72) = ra1;                                               \
        *(uint4*)(a_ + 128 * 72) = ra2;                                              \
        *(uint4*)(a_ + 192 * 72) = ra3;                                              \
    }
#define LSTORE_B(BUF)                                                                \
    {                                                                                \
        bf16_t* b_ = Bs + (size_t)(BUF) * BN * 72 + arow * 72 + akc;                 \
        *(uint4*)(b_) = rb0;                                                         \
        *(uint4*)(b_ + 64 * 72) = rb1;                                               \
        if (BN == 256) {                                                             \
            *(uint4*)(b_ + 128 * 72) = rb2;                                          \
            *(uint4*)(b_ + 192 * 72) = rb3;                                          \
        }                                                                            \
    }
#define GEMM_KS(ks)                                                                                                                 \
    {                                                                                                                               \
        bf16x8 bf[4];                                                                                                               \
        _Pragma("unroll") for (int ni = 0; ni < 4; ++ni) bf[ni] = *(const bf16x8*)(Bb + ni * 16 * 72 + (ks) * 32);                  \
        _Pragma("unroll") for (int h = 0; h < MT; ++h) {                                                                            \
            bf16x8 af[4];                                                                                                           \
            _Pragma("unroll") for (int mi = 0; mi < 4; ++mi) af[mi] = *(const bf16x8*)(Ab + (h * 64 + mi * 16) * 72 + (ks) * 32);   \
            __builtin_amdgcn_s_setprio(1);                                                                                          \
            _Pragma("unroll") for (int mi = 0; mi < 4; ++mi)                                                                        \
                _Pragma("unroll") for (int ni = 0; ni < 4; ++ni)                                                                    \
                    acc[h][mi][ni] = __builtin_amdgcn_mfma_f32_16x16x32_bf16(bf[ni], af[mi], acc[h][mi][ni], 0, 0, 0);              \
            __builtin_amdgcn_s_setprio(0);                                                                                          \
        }                                                                                                                           \
    }
    {
        GLOAD_AALL(0)
        __syncthreads();
        LSTORE_A(0)
    }
    {
        GLOAD_BALL(0)
        LSTORE_B(0)
    }
    __syncthreads();
    for (int kt = 0; kt < nk; ++kt) {
        const int cur = kt & 1;
        const bool nxt = kt + 1 < nk;
        const bf16_t* Ab = As + (size_t)cur * 256 * 72 + (wr * 64 * MT + fr) * 72 + fq * 8;
        const bf16_t* Bb = Bs + (size_t)cur * BN * 72 + (wc * 64 + fr) * 72 + fq * 8;
        if (nxt) { GLOAD_AALL(kt + 1) }
        GEMM_KS(0)
        if (nxt) { LSTORE_A(cur ^ 1) GLOAD_BALL(kt + 1) }
        GEMM_KS(1)
        if (nxt) LSTORE_B(cur ^ 1)
        __syncthreads();
    }
}
#define GEMM_WROW(BN_) ((BN_) == 256 ? ((tid_l >> 8) * 128) : ((tid_l >> 7) * 64))
#define GEMM_WCOL(BN_) ((BN_) == 256 ? (((tid_l >> 6) & 3) * 64) : (((tid_l >> 6) & 1) * 64))


__device__ __forceinline__ bool xcd_tile(int u, int ntn, bool lat_only, int& tm, int& tn) {
    const int x = blockIdx.x & 7;
    const int np = lat_only ? 32 : 33, p0 = lat_only ? 1 : 0;
    if (u >= np * ntn) return false;
    const int g = u / (4 * ntn), v = u - g * 4 * ntn;
    const int gsz = (np - 4 * g) < 4 ? (np - 4 * g) : 4;
    tn = v / gsz;
    tm = 33 * x + p0 + 4 * g + (v - tn * gsz);
    return true;
}

__device__ __forceinline__ void epi_qkv(f32x4 (&acc)[4][4], int row0, int col0, int lane, bf16_t* Q, bf16_t* Kx, bf16_t* VT, const float* qg, const float* kg,
                                        const float* rope) {
    const int fr = lane & 15, fq = lane >> 4;
    if (col0 >= 1280) {
        const int kvh = (col0 - 1280) >> 6;
#pragma unroll
        for (int mi = 0; mi < 4; ++mi) {
            const int row = row0 + mi * 16 + fr, b = row / PB, pp = row - b * PB;
            bf16_t* vb = VT + ((size_t)(b * 4 + kvh) * 64) * PB + pp;
#pragma unroll
            for (int ni = 0; ni < 4; ++ni)
#pragma unroll
                for (int j = 0; j < 4; ++j) vb[(size_t)(ni * 16 + fq * 4 + j) * PB] = f2bf(acc[mi][ni][j]);
        }
        return;
    }
    const bool isq = col0 < 1024;
    const float* gain = isq ? qg : kg;
#pragma unroll
    for (int mi = 0; mi < 4; ++mi) {
        float ss = 0.f;
#pragma unroll
        for (int ni = 0; ni < 4; ++ni)
#pragma unroll
            for (int j = 0; j < 4; ++j) ss += acc[mi][ni][j] * acc[mi][ni][j];
        ss = xsum16_32(ss);
        const float rstd = rsqrtf(ss * (1.0f / 64.0f) + 1e-6f);
        f32x4 v[4];
#pragma unroll
        for (int ni = 0; ni < 4; ++ni) v[ni] = (acc[mi][ni] * rstd) * *(const f32x4*)(gain + ni * 16 + fq * 4);
        const int row = row0 + mi * 16 + fr, b = row / PB, pp = row - b * PB;
        if (pp >= CTXL) {
            const int l = pp - CTXL, prow = l >> 6, pcol = l & 63;
#pragma unroll
            for (int a = 0; a < 2; ++a) {
                const int pos = a ? pcol : prow;
                f32x4 cs = *(const f32x4*)(rope + pos * 16 + fq * 4), sn = *(const f32x4*)(rope + 2048 + pos * 16 + fq * 4);
                f32x4 x1 = v[2 * a], x2 = v[2 * a + 1];
                v[2 * a] = x1 * cs - x2 * sn;
                v[2 * a + 1] = x1 * sn + x2 * cs;
            }
        }
        if (isq) {
#pragma unroll
            for (int ni = 0; ni < 4; ++ni) st4bf(Q + (size_t)row * 1024 + col0 + ni * 16 + fq * 4, v[ni] * (0.125f * 1.44269504088896f));
        } else {
#pragma unroll
            for (int ni = 0; ni < 4; ++ni) st4bf(Kx + (size_t)row * 256 + (col0 - 1024) + ni * 16 + fq * 4, v[ni]);
        }
    }
}

__device__ __forceinline__ void epi_res(f32x4 (&acc)[4][4], int row0, int col0, int lane, const float* slat, const float* sctx, float* dlat, float* dctx,
                                        const float* modl, int gI, float dbg_scale = 1.0f) {
    const int fr = lane & 15, fq = lane >> 4;
#pragma unroll
    for (int mi = 0; mi < 4; ++mi) {
        const int row = row0 + mi * 16 + fr;
        const float* sp = xrow(slat, sctx, row);
        float* dp = xrow(dlat, dctx, row);
        const float* gp = modl + (size_t)modrow(row) * 6144 + gI * 1024;
#pragma unroll
        for (int ni = 0; ni < 4; ++ni) {
            const int col = col0 + ni * 16 + fq * 4;
            f32x4 s = *(const f32x4*)(sp + col), gt = *(const f32x4*)(gp + col);
            f32x4 av = acc[mi][ni];
#ifdef DBG_CLAMPY
            for (int j = 0; j < 4; ++j) av[j] = fminf(fmaxf(av[j], -1.f), 1.f);
#endif
#ifdef DBG_CLAMPG
            for (int j = 0; j < 4; ++j) gt[j] = fminf(fmaxf(gt[j], -1.f), 1.f);
#endif
            *(f32x4*)(dp + col) = s + gt * av * dbg_scale;
        }
    }
}

__device__ __forceinline__ void epi_swiglu(f32x4 (&acc)[4][4], int row0, int col0, int lane, bf16_t* ACT) {
    const int fr = lane & 15, fq = lane >> 4;
#pragma unroll
    for (int mi = 0; mi < 4; ++mi) {
        const int row = row0 + mi * 16 + fr;
#pragma unroll
        for (int h2 = 0; h2 < 2; ++h2) {
            f32x4 gt = acc[mi][2 * h2], up = acc[mi][2 * h2 + 1], o;
#pragma unroll
            for (int j = 0; j < 4; ++j) o[j] = fsilu(gt[j]) * up[j];
            st4bf(ACT + (size_t)row * DFF + (col0 >> 1) + h2 * 16 + fq * 4, o);
        }
    }
}

template <int ACTF>
__device__ __forceinline__ void epi_store(f32x4 (&acc)[4][4], int row0, int col0, int lane, bf16_t* O, int ldo) {
    const int fr = lane & 15, fq = lane >> 4;
#pragma unroll
    for (int mi = 0; mi < 4; ++mi) {
        const int row = row0 + mi * 16 + fr;
#pragma unroll
        for (int ni = 0; ni < 4; ++ni) {
            f32x4 v = acc[mi][ni];
            if (ACTF == 1) {
#pragma unroll
                for (int j = 0; j < 4; ++j) v[j] = ftanh(v[j]);
            }
            if (ACTF == 2) {
#pragma unroll
                for (int j = 0; j < 4; ++j) v[j] = fsigmoid(v[j]);
            }
            st4bf(O + (size_t)row * ldo + col0 + ni * 16 + fq * 4, v);
        }
    }
}

__device__ __forceinline__ void epi_kstore(f32x4 (&acc)[4][4], int row0, int col0, int lane, bf16_t* O, const float* k_k, float* KKN) {
    const int fr = lane & 15, fq = lane >> 4;
    f32x4 kkv[4];
#pragma unroll
    for (int ni = 0; ni < 4; ++ni) kkv[ni] = *(const f32x4*)(k_k + col0 + ni * 16 + fq * 4);
#pragma unroll
    for (int mi = 0; mi < 4; ++mi) {
        const int row = row0 + mi * 16 + fr;
        float ss = 0.f;
#pragma unroll
        for (int ni = 0; ni < 4; ++ni) {
            f32x4 t = acc[mi][ni] * kkv[ni];
            ss += t[0] * t[0] + t[1] * t[1] + t[2] * t[2] + t[3] * t[3];
            st4bf(O + (size_t)row * 1024 + col0 + ni * 16 + fq * 4, acc[mi][ni]);
        }
        ss = xsum16_32(ss);
        if (fq == 0) KKN[(size_t)row * 16 + (col0 >> 6)] = rsqrtf(fmaxf(ss, 1e-24f));
    }
}

__device__ __forceinline__ void epi_readout(f32x4 (&acc)[4][4], int row0, int col0, int lane, const bf16_t* Y0, const bf16_t* Y1, const float* BS, const bf16_t* V,
                                            const float* lng, const float* lnb, bf16_t* Z) {
    const int fr = lane & 15, fq = lane >> 4, hd = col0 >> 6;
    f32x4 lg[4], lb[4];
#pragma unroll
    for (int ni = 0; ni < 4; ++ni) {
        lg[ni] = *(const f32x4*)(lng + col0 + ni * 16 + fq * 4);
        lb[ni] = *(const f32x4*)(lnb + col0 + ni * 16 + fq * 4);
    }
#pragma unroll
    for (int mi = 0; mi < 4; ++mi) {
        const int row = row0 + mi * 16 + fr, b = row / PB, pp = row - b * PB;
        const size_t li = (size_t)b * SEQL + (pp - CTXL);
        f32x4 wk[4];
        float s = 0.f;
#pragma unroll
        for (int ni = 0; ni < 4; ++ni) {
            const int col = col0 + ni * 16 + fq * 4;
            wk[ni] = ld4bf(Y0 + li * 1024 + col) + ld4bf(Y1 + li * 1024 + col);
            s += wk[ni][0] + wk[ni][1] + wk[ni][2] + wk[ni][3];
        }
        s = xsum16_32(s);
        const float mu = s * (1.0f / 64.0f);
        float q = 0.f;
#pragma unroll
        for (int ni = 0; ni < 4; ++ni) {
            wk[ni] = wk[ni] - mu;
            q += wk[ni][0] * wk[ni][0] + wk[ni][1] * wk[ni][1] + wk[ni][2] * wk[ni][2] + wk[ni][3] * wk[ni][3];
        }
        q = xsum16_32(q);
        const float rstd = rsqrtf(q * (1.0f / 64.0f) + 64e-5f);
        const float bsv = BS[(size_t)row * 16 + hd] + BS[(size_t)RT * 16 + (size_t)row * 16 + hd];
#pragma unroll
        for (int ni = 0; ni < 4; ++ni) {
            const int col = col0 + ni * 16 + fq * 4;
            f32x4 vv = ld4bf(V + (size_t)row * 1024 + col);
            f32x4 z = ((wk[ni] * rstd) * lg[ni] + lb[ni] + vv * bsv) * acc[mi][ni];
            st4bf(Z + (size_t)row * 1024 + col, z);
        }
    }
}

__device__ void attn_phase(const bf16_t* Q, const bf16_t* Kx, const bf16_t* VT, bf16_t* O, const float* qg, const float* kg, char* smem) {
    const int tid = threadIdx.x, lane = tid & 63, w = tid >> 6, fr = lane & 15, fq = lane >> 4;
    bf16_t* Ks = (bf16_t*)smem;
    bf16_t* Vs = Ks + 2 * 64 * 72;
    const int xcd = blockIdx.x & 7, slot = blockIdx.x >> 3, nslots = gridDim.x >> 3;
    float gqm = 0.f, gkm = 0.f;
    for (int d = 0; d < 64; ++d) { gqm = fmaxf(gqm, fabsf(qg[d])); gkm = fmaxf(gkm, fabsf(kg[d])); }
    const float mfix = 8.0f * gqm * gkm * 1.44269504088896f * 1.0001f;
    const int lrow = tid >> 3, lch = (tid & 7) * 8;
    for (int it = slot; it < 528; it += nslots) {
        int pr, g, qb;
        if (it < 512) { pr = it >> 7; g = (it >> 5) & 3; qb = 1 + (it & 31); }
        else { const int li = it - 512; pr = li >> 2; g = li & 3; qb = 0; }
        const int pair = xcd + 8 * pr, b = pair >> 2, kvh = pair & 3, hq = kvh * 4 + g;
        const int nt = (qb == 0 ? CTXL : PB) >> 6;
        const int rowbase = b * PB + qb * 256 + w * 32;
        bf16x8 qf[2][2];
#pragma unroll
        for (int qt = 0; qt < 2; ++qt)
#pragma unroll
            for (int ks = 0; ks < 2; ++ks) qf[qt][ks] = *(const bf16x8*)(Q + (size_t)(rowbase + qt * 16 + fr) * 1024 + hq * 64 + ks * 32 + fq * 8);
        const bf16_t* kp = Kx + (size_t)(b * PB + lrow) * 256 + kvh * 64 + lch;
        const bf16_t* vp = VT + ((size_t)(b * 4 + kvh) * 64 + lrow) * PB + lch;
        f32x4 Oa[4][2];
#pragma unroll
        for (int dt = 0; dt < 4; ++dt)
#pragma unroll
            for (int qt = 0; qt < 2; ++qt) Oa[dt][qt] = (f32x4){0.f, 0.f, 0.f, 0.f};
        f32x4 Ol[2] = {(f32x4){0.f, 0.f, 0.f, 0.f}, (f32x4){0.f, 0.f, 0.f, 0.f}};
        uint4 rk = *(const uint4*)kp, rv = *(const uint4*)vp;
        __syncthreads();
        *(uint4*)(Ks + lrow * 72 + lch) = rk;
        *(uint4*)(Vs + lrow * 72 + lch) = rv;
        __syncthreads();
        for (int t = 0; t < nt; ++t) {
            const int cur = t & 1;
            if (t + 1 < nt) {
                rk = *(const uint4*)(kp + (size_t)(t + 1) * 64 * 256);
                rv = *(const uint4*)(vp + (t + 1) * 64);
            }
            const bf16_t* Kb = Ks + cur * 64 * 72;
            const bf16_t* Vb = Vs + cur * 64 * 72;
            f32x4 S[2][4];
#pragma unroll
            for (int kt = 0; kt < 4; ++kt) {
                bf16x8 k0 = *(const bf16x8*)(Kb + (kt * 16 + fr) * 72 + fq * 8), k1 = *(const bf16x8*)(Kb + (kt * 16 + fr) * 72 + 32 + fq * 8);
#pragma unroll
                for (int qt = 0; qt < 2; ++qt) {
                    f32x4 z = (f32x4){-mfix, -mfix, -mfix, -mfix};
                    z = __builtin_amdgcn_mfma_f32_16x16x32_bf16(k0, qf[qt][0], z, 0, 0, 0);
                    S[qt][kt] = __builtin_amdgcn_mfma_f32_16x16x32_bf16(k1, qf[qt][1], z, 0, 0, 0);
                }
            }
            bf16x8 pf[2][2];
#pragma unroll
            for (int qt = 0; qt < 2; ++qt) {
#pragma unroll
                for (int kt = 0; kt < 4; ++kt) {
                    f32x4 e = S[qt][kt];
#pragma unroll
                    for (int j = 0; j < 4; ++j) e[j] = __builtin_amdgcn_exp2f(e[j]);
                    S[qt][kt] = e;
                }
#pragma unroll
                for (int s2 = 0; s2 < 2; ++s2) {
                    uint4 u;
                    u.x = pk2(S[qt][2 * s2][0], S[qt][2 * s2][1]);
                    u.y = pk2(S[qt][2 * s2][2], S[qt][2 * s2][3]);
                    u.z = pk2(S[qt][2 * s2 + 1][0], S[qt][2 * s2 + 1][1]);
                    u.w = pk2(S[qt][2 * s2 + 1][2], S[qt][2 * s2 + 1][3]);
                    pf[qt][s2] = __builtin_bit_cast(bf16x8, u);
                }
            }
            {
                const uint4 uo = make_uint4(0x3f803f80u, 0x3f803f80u, 0x3f803f80u, 0x3f803f80u);
                const bf16x8 vones = __builtin_bit_cast(bf16x8, uo);
#pragma unroll
                for (int s2 = 0; s2 < 2; ++s2)
#pragma unroll
                    for (int qt = 0; qt < 2; ++qt) Ol[qt] = __builtin_amdgcn_mfma_f32_16x16x32_bf16(vones, pf[qt][s2], Ol[qt], 0, 0, 0);
            }
#pragma unroll
            for (int dt = 0; dt < 4; ++dt)
#pragma unroll
                for (int s2 = 0; s2 < 2; ++s2) {
                    uint2 v0 = *(const uint2*)(Vb + (dt * 16 + fr) * 72 + s2 * 32 + fq * 4), v1 = *(const uint2*)(Vb + (dt * 16 + fr) * 72 + s2 * 32 + 16 + fq * 4);
                    uint4 u = make_uint4(v0.x, v0.y, v1.x, v1.y);
                    bf16x8 vf = __builtin_bit_cast(bf16x8, u);
#pragma unroll
                    for (int qt = 0; qt < 2; ++qt) Oa[dt][qt] = __builtin_amdgcn_mfma_f32_16x16x32_bf16(vf, pf[qt][s2], Oa[dt][qt], 0, 0, 0);
                }
            if (t + 1 < nt) {
                *(uint4*)(Ks + (cur ^ 1) * 64 * 72 + lrow * 72 + lch) = rk;
                *(uint4*)(Vs + (cur ^ 1) * 64 * 72 + lrow * 72 + lch) = rv;
            }
            __syncthreads();
        }
#pragma unroll
        for (int qt = 0; qt < 2; ++qt) {
            const float inv = 1.0f / Ol[qt][0];
            bf16_t* op = O + (size_t)(rowbase + qt * 16 + fr) * 1024 + hq * 64 + fq * 4;
#pragma unroll
            for (int dt = 0; dt < 4; ++dt) {
                f32x4 ov = Oa[dt][qt] * inv;
#ifdef DBG_CLAMPO
                for (int j = 0; j < 4; ++j) ov[j] = fminf(fmaxf(ov[j], -8.f), 8.f);
#endif
                st4bf(op + dt * 16, ov);
            }
        }
    }
}

#define DPPB(J) " row_newbcast:" #J " row_mask:0xf bank_mask:0xf bound_ctrl:1"
#define FMAC_BC(ACC, X, Y, J) asm volatile("v_fmac_f32_dpp %0, %1, %2" DPPB(J) : "+v"(ACC) : "v"(X), "v"(Y))
#define MUL_BC(D, X, Y, J) asm volatile("v_mul_f32_dpp %0, %1, %2" DPPB(J) : "=v"(D) : "v"(X), "v"(Y))
#define SCAN_J(J)                                  \
    MUL_BC(S[J], wv, S[J], J);                     \
    FMAC_BC(S[J], bv, sa, J);                      \
    FMAC_BC(S[J], kdv, vv, J);
#define R1_J(A, J) FMAC_BC(A, unv, S[J], J);
#define UPD_J(J)                                   \
    FMAC_BC(S[J], bv, sa, J);                      \
    FMAC_BC(S[J], kdv, vv, J);
#define RSC_J(J) MUL_BC(S[J], dl, S[J], J);
#define UPA_J(J) FMAC_BC(S[J], bv, sa, J);
#define UPB_J(J) FMAC_BC(S[J], kdv, vv, J);
#define Y_J(A, J) FMAC_BC(A, rv, S[J], J);

__device__ void scan_phase(const Pm& p, char* smem) {
    const int tid = threadIdx.x, lane = tid & 63, w = tid >> 6, fr = lane & 15, fq = lane >> 4;
    char* ws = p.ws;
    float* cb = (float*)smem;
    float* yp = cb + 2 * 6144;
    float* bp = yp + 2 * 8192;
    float* cp = bp + 4 * 64;
    const bf16_t* Rr = (const bf16_t*)(ws + A1_R);
    const bf16_t* Kk = (const bf16_t*)(ws + A1_K);
    const bf16_t* Vv = (const bf16_t*)(ws + A1_V);
    const bf16_t* TW = (const bf16_t*)(ws + A1_TW);
    const bf16_t* TA = (const bf16_t*)(ws + A1_TA);
    const float* KKN = (const float*)(ws + OFF_KKN);
    const int NCH = PB / 16;
    for (int item = blockIdx.x; item < 256; item += gridDim.x) {
        const int b = item >> 5, dir = (item >> 4) & 1, h = item & 15;
        bf16_t* Y = (bf16_t*)(ws + (dir ? A1_Y1 : A1_Y0));
        float* BS = (float*)(ws + OFF_BS) + (size_t)dir * RT * 16;
        __syncthreads();
        if (w >= 4) {
            const int pw = w - 4, ch = h * 64 + pw * 16 + fq * 4;
            bf16x8 w2f[2], a2f[2];
#pragma unroll
            for (int ks = 0; ks < 2; ++ks) {
                w2f[ks] = *(const bf16x8*)((const bf16_t*)(ws + OFF_W2T) + ((size_t)dir * 1024 + h * 64 + pw * 16 + fr) * 64 + ks * 32 + fq * 8);
                a2f[ks] = *(const bf16x8*)((const bf16_t*)(ws + OFF_A2T) + ((size_t)dir * 1024 + h * 64 + pw * 16 + fr) * 64 + ks * 32 + fq * 8);
            }
            const f32x4 w0v = *(const f32x4*)(p.w0 + dir * 1024 + ch), a0v = *(const f32x4*)(p.a0 + dir * 1024 + ch);
            const f32x4 kkc = *(const f32x4*)(p.k_k + ch), kac = *(const f32x4*)(p.k_a + ch), rkc = *(const f32x4*)(p.r_k + ch);
            const int pt = tid - 256;
            struct Raw { bf16x8 tw0, tw1, ta0, ta1; uint2 k, v, r, k1; float kn, kn1; };
            auto load_raw = [&](int chunk, Raw& q) {
                const int n = chunk * 16 + fr;
                const int pp = n < CTXL ? (dir ? CTXL - 1 - n : n) : (dir ? (PB + CTXL - 1) - n : n);
                const int n1 = n + 1;
                const int pp1 = n1 < CTXL ? (dir ? CTXL - 1 - n1 : n1) : (dir ? (PB + CTXL - 1) - n1 : n1);
                const size_t row = (size_t)b * PB + pp;
                const size_t row1 = (size_t)b * PB + (n1 < PB ? pp1 : pp);
                q.tw0 = *(const bf16x8*)(TW + row * 128 + dir * 64 + fq * 8);
                q.tw1 = *(const bf16x8*)(TW + row * 128 + dir * 64 + 32 + fq * 8);
                q.ta0 = *(const bf16x8*)(TA + row * 128 + dir * 64 + fq * 8);
                q.ta1 = *(const bf16x8*)(TA + row * 128 + dir * 64 + 32 + fq * 8);
                q.k = *(const uint2*)(Kk + row * 1024 + ch);
                q.v = *(const uint2*)(Vv + row * 1024 + ch);
                q.r = *(const uint2*)(Rr + row * 1024 + ch);
                q.k1 = *(const uint2*)(Kk + row1 * 1024 + ch);
                q.kn = KKN[row * 16 + h];
                q.kn1 = n1 < PB ? KKN[row1 * 16 + h] : 0.f;
            };
            Raw cur, nxt;
            load_raw(0, cur);
            nxt = cur;
            for (int c = -1; c < NCH; ++c) {
                if (c + 2 < NCH) load_raw(c + 2, nxt);
                if (c + 1 < NCH) {
                    const int buf = (c + 1) & 1;
                    f32x4 wp = (f32x4){0.f, 0.f, 0.f, 0.f}, ap = (f32x4){0.f, 0.f, 0.f, 0.f};
                    wp = __builtin_amdgcn_mfma_f32_16x16x32_bf16(w2f[0], cur.tw0, wp, 0, 0, 0);
                    wp = __builtin_amdgcn_mfma_f32_16x16x32_bf16(w2f[1], cur.tw1, wp, 0, 0, 0);
                    ap = __builtin_amdgcn_mfma_f32_16x16x32_bf16(a2f[0], cur.ta0, ap, 0, 0, 0);
                    ap = __builtin_amdgcn_mfma_f32_16x16x32_bf16(a2f[1], cur.ta1, ap, 0, 0, 0);
                    const f32x4 k4 = (f32x4){bflo(cur.k.x), bfhi(cur.k.x), bflo(cur.k.y), bfhi(cur.k.y)};
                    const f32x4 v4 = (f32x4){bflo(cur.v.x), bfhi(cur.v.x), bflo(cur.v.y), bfhi(cur.v.y)};
                    const f32x4 r4 = (f32x4){bflo(cur.r.x), bfhi(cur.r.x), bflo(cur.r.y), bfhi(cur.r.y)};
                    const f32x4 k4n = (f32x4){bflo(cur.k1.x), bfhi(cur.k1.x), bflo(cur.k1.y), bfhi(cur.k1.y)};
                    const float kn = cur.kn, kn1 = cur.kn1;
                    f32x4 dec, un4, b4, kd4;
                    float bsum = 0.f, c1 = 0.f, c2 = 0.f;
#pragma unroll
                    for (int j = 0; j < 4; ++j) {
                        const float z = -(w0v[j] + wp[j]);
                        const float sp = fmaxf(z, 0.f) + __logf(1.0f + __expf(-fabsf(z)));
                        const float wl = -sp - 0.5f;
                        dec[j] = __expf(-__expf(wl));
                        const float a = fsigmoid(a0v[j] + ap[j]);
                        kd4[j] = k4[j] * (1.0f + (a - 1.0f) * kac[j]);
                        const float kk = k4[j] * kkc[j] * kn;
                        const float kkn1 = k4n[j] * kkc[j] * kn1;
                        b4[j] = kk * a;
                        un4[j] = dec[j] * kkn1;
                        c1 += b4[j] * kkn1;
                        c2 += kd4[j] * kkn1;
                        bsum += r4[j] * kd4[j] * rkc[j];
                    }
                    f32x4 D = dec;
#pragma unroll
                    for (int dd = 1; dd < 16; dd <<= 1) {
                        f32x4 up;
#pragma unroll
                        for (int j = 0; j < 4; ++j) up[j] = __shfl_up(D[j], dd, 16);
                        if (fr >= dd) D = D * up;
                    }
                    f32x4 invD, Dm1;
#pragma unroll
                    for (int j = 0; j < 4; ++j) { invD[j] = 1.0f / D[j]; Dm1[j] = D[j] / dec[j]; }
                    float* cbb = cb + buf * 6144 + fr * 64 + pw * 16 + fq * 4;
                    *(f32x4*)(cbb + 0 * 1024) = D;
                    *(f32x4*)(cbb + 1 * 1024) = un4 * (-Dm1);
                    *(f32x4*)(cbb + 2 * 1024) = b4 * invD;
                    *(f32x4*)(cbb + 3 * 1024) = kd4 * invD;
                    *(f32x4*)(cbb + 4 * 1024) = r4 * D;
                    *(f32x4*)(cbb + 5 * 1024) = v4;
                    bsum = xsum16_32(bsum);
                    c1 = xsum16_32(c1);
                    c2 = xsum16_32(c2);
                    if (fq == 0) {
                        bp[((c + 1) & 3) * 64 + fr * 4 + pw] = bsum;
                        cp[buf * 128 + fr * 8 + pw * 2] = c1;
                        cp[buf * 128 + fr * 8 + pw * 2 + 1] = c2;
                    }
                }
                if (c >= 1 && (c - 1) * 16 >= CTXL) {
                    const int co = c - 1, buf = co & 1;
                    const int tt = pt >> 4, vq = (pt & 15) * 4, n = co * 16 + tt;
                    const int pp = dir ? (PB + CTXL - 1) - n : n;
                    const float* ypb = yp + buf * 8192 + tt * 512 + vq * 2;
                    f32x4 ya = *(const f32x4*)(ypb), yb = *(const f32x4*)(ypb + 4);
#pragma unroll
                    for (int e = 1; e < 4; ++e) { ya += *(const f32x4*)(ypb + e * 128); yb += *(const f32x4*)(ypb + e * 128 + 4); }
                    f32x4 ys = (f32x4){ya[0] + ya[1], ya[2] + ya[3], yb[0] + yb[1], yb[2] + yb[3]};
                    st4bf(Y + ((size_t)b * SEQL + (pp - CTXL)) * 1024 + h * 64 + vq, ys);
                    if ((pt & 15) == 0) {
                        const float* bb = bp + (co & 3) * 64 + tt * 4;
                        BS[((size_t)b * PB + pp) * 16 + h] = bb[0] + bb[1] + bb[2] + bb[3];
                    }
                }
                __syncthreads();
                cur = nxt;
            }
            {
                const int co = NCH - 1, buf = co & 1;
                const int tt = pt >> 4, vq = (pt & 15) * 4, n = co * 16 + tt;
                const int pp = dir ? (PB + CTXL - 1) - n : n;
                const float* ypb = yp + buf * 8192 + tt * 512 + vq * 2;
                f32x4 ya = *(const f32x4*)(ypb), yb = *(const f32x4*)(ypb + 4);
#pragma unroll
                for (int e = 1; e < 4; ++e) { ya += *(const f32x4*)(ypb + e * 128); yb += *(const f32x4*)(ypb + e * 128 + 4); }
                f32x4 ys = (f32x4){ya[0] + ya[1], ya[2] + ya[3], yb[0] + yb[1], yb[2] + yb[3]};
                st4bf(Y + ((size_t)b * SEQL + (pp - CTXL)) * 1024 + h * 64 + vq, ys);
                if ((pt & 15) == 0) {
                    const float* bb = bp + (co & 3) * 64 + tt * 4;
                    BS[((size_t)b * PB + pp) * 16 + h] = bb[0] + bb[1] + bb[2] + bb[3];
                }
            }
        } else {
            float S[16];
#pragma unroll
            for (int j = 0; j < 16; ++j) S[j] = 0.f;
            float R1 = 0.f, sa_prev = 0.f, v_prev = 0.f, c1p = 0.f, c2p = 0.f;
            float py0 = 0.f, py1 = 0.f, py2 = 0.f, py3 = 0.f;
            const int bpa16 = (lane ^ 16) << 2, bpa32 = (lane ^ 32) << 2;
            __syncthreads();
            for (int c = 0; c < NCH; ++c) {
                const float* cbb = cb + (c & 1) * 6144 + lane;
                const float* cvb = cb + (c & 1) * 6144 + 5 * 1024 + w * 16 + fr;
                const float* cpb = cp + (c & 1) * 128;
                float* ypb = yp + (c & 1) * 8192 + (fq * 64 + w * 16 + fr) * 2;
                float unv_n = cbb[1 * 1024], bv_n = cbb[2 * 1024], kdv_n = cbb[3 * 1024], rv_n = cbb[4 * 1024], vv_n = cvb[0];
                float c1v, c2v;
                {
                    const f32x4 q0 = *(const f32x4*)(cpb + fr * 8), q1 = *(const f32x4*)(cpb + fr * 8 + 4);
                    c1v = -((q0[0] + q0[2]) + (q1[0] + q1[2]));
                    c2v = -((q0[1] + q0[3]) + (q1[1] + q1[3]));
                }
#pragma unroll
                for (int tt = 0; tt < 16; ++tt) {
                    const float unv = unv_n, bv = bv_n, kdv = kdv_n, rv = rv_n, vv = vv_n;
                    if (tt < 15) {
                        unv_n = cbb[1 * 1024 + (tt + 1) * 64]; bv_n = cbb[2 * 1024 + (tt + 1) * 64]; kdv_n = cbb[3 * 1024 + (tt + 1) * 64];
                        rv_n = cbb[4 * 1024 + (tt + 1) * 64]; vv_n = cvb[(tt + 1) * 64];
                    }
                    const float sa = fmaf(v_prev, c2p, fmaf(sa_prev, c1p, R1));
                    float s0, s1, s2, s3;
                    MUL_BC(s0, unv, S[0], 0); MUL_BC(s1, unv, S[1], 1); MUL_BC(s2, unv, S[2], 2); MUL_BC(s3, unv, S[3], 3);
                    R1_J(s0, 4) R1_J(s1, 5) R1_J(s2, 6) R1_J(s3, 7)
                    R1_J(s0, 8) R1_J(s1, 9) R1_J(s2, 10) R1_J(s3, 11) R1_J(s0, 12) R1_J(s1, 13) R1_J(s2, 14) R1_J(s3, 15)
                    UPA_J(0) UPA_J(1) UPA_J(2) UPA_J(3) UPA_J(4) UPA_J(5) UPA_J(6) UPA_J(7)
                    UPA_J(8) UPA_J(9) UPA_J(10) UPA_J(11) UPA_J(12) UPA_J(13) UPA_J(14) UPA_J(15)
                    asm volatile("v_add_f32 %0, %0, %1" : "+v"(s0) : "v"(s1));
                    asm volatile("v_add_f32 %0, %0, %1" : "+v"(s2) : "v"(s3));
                    float t1 = s0;
                    asm volatile("v_add_f32 %0, %0, %1" : "+v"(t1) : "v"(s2));
                    const float x1 = __builtin_bit_cast(float, __builtin_amdgcn_ds_bpermute(bpa16, __builtin_bit_cast(int, t1)));
                    if (tt > 0) {
                        asm volatile("v_add_f32 %0, %0, %1" : "+v"(py0) : "v"(py1));
                        asm volatile("v_add_f32 %0, %0, %1" : "+v"(py2) : "v"(py3));
                        *(float2*)(ypb + (tt - 1) * 512) = make_float2(py0, py2);
                    }
                    UPB_J(0) UPB_J(1) UPB_J(2) UPB_J(3) UPB_J(4) UPB_J(5) UPB_J(6) UPB_J(7)
                    UPB_J(8) UPB_J(9) UPB_J(10) UPB_J(11) UPB_J(12) UPB_J(13) UPB_J(14) UPB_J(15)
                    float t2 = t1;
                    asm volatile("v_add_f32 %0, %0, %1" : "+v"(t2) : "v"(x1));
                    const float x2 = __builtin_bit_cast(float, __builtin_amdgcn_ds_bpermute(bpa32, __builtin_bit_cast(int, t2)));
                    float y0, y1, y2, y3;
                    MUL_BC(y0, rv, S[0], 0); MUL_BC(y1, rv, S[1], 1); MUL_BC(y2, rv, S[2], 2); MUL_BC(y3, rv, S[3], 3);
                    Y_J(y0, 4) Y_J(y1, 5) Y_J(y2, 6) Y_J(y3, 7)
                    Y_J(y0, 8) Y_J(y1, 9) Y_J(y2, 10) Y_J(y3, 11) Y_J(y0, 12) Y_J(y1, 13) Y_J(y2, 14) Y_J(y3, 15)
                    py0 = y0; py1 = y1; py2 = y2; py3 = y3;
                    R1 = t2;
                    asm volatile("v_add_f32 %0, %0, %1" : "+v"(R1) : "v"(x2));
                    sa_prev = sa;
                    v_prev = vv;
                    c1p = __builtin_bit_cast(float, __builtin_amdgcn_readlane(__builtin_bit_cast(int, c1v), tt));
                    c2p = __builtin_bit_cast(float, __builtin_amdgcn_readlane(__builtin_bit_cast(int, c2v), tt));
                }
                {
                    const float dl = cbb[0 * 1024 + 15 * 64];
                    RSC_J(0) RSC_J(1) RSC_J(2) RSC_J(3) RSC_J(4) RSC_J(5) RSC_J(6) RSC_J(7)
                    RSC_J(8) RSC_J(9) RSC_J(10) RSC_J(11) RSC_J(12) RSC_J(13) RSC_J(14) RSC_J(15)
                    asm volatile("v_add_f32 %0, %0, %1" : "+v"(py0) : "v"(py1));
                    asm volatile("v_add_f32 %0, %0, %1" : "+v"(py2) : "v"(py3));
                    *(float2*)(ypb + 15 * 512) = make_float2(py0, py2);
                }
                __syncthreads();
            }
        }
        __syncthreads();
    }
}

#define NPHASE 17
#ifndef PH_MASK
#define PH_MASK 0x1ffff
#endif
#define PHON(n) ((PH_MASK >> (n)) & 1)
#ifndef DBG_ZMASK
#define DBG_ZMASK 0
#endif
template <int PH> __device__ __forceinline__ void run_phase(const Pm& p, char* smem) {
    char* ws = p.ws;
    int tid_l = threadIdx.x;
    asm volatile("" : "+v"(tid_l));
    const int G = gridDim.x, lane = tid_l & 63;
    const float* MOD0 = (const float*)(ws + OFF_MOD);
    const float* MOD1 = MOD0 + 9 * 6144;
    float* XC = (float*)(ws + OFF_XC);
    {
        switch (PH) {
        case 0: if (!PHON(0)) break; phase0(p, smem); break;
        case 1: if (!PHON(1)) break; norm_phase<0>(p.x, p.ctx, p.n1g, MOD0, 0, 1, (bf16_t*)(ws + A0_H), nullptr, false); break;
        case 2: if (!PHON(2)) break; {
            GemmArgs ga{(const bf16_t*)(ws + A0_H), nullptr, nullptr, (const bf16_t*)(ws + OFF_WQKV), 1024, 1024};
            for (int u = blockIdx.x >> 3, tm, tn; xcd_tile(u, 6, false, tm, tn); u += (G >> 3)) {
                f32x4 acc[2][4][4];
                gemm_main<0, 256>(ga, tm, tn, acc, smem);
                for (int hh = 0; hh < 2; ++hh)
                epi_qkv(acc[hh], tm * 256 + GEMM_WROW(256) + hh * 64, tn * 256 + GEMM_WCOL(256), lane, (bf16_t*)(ws + A0_Q), (bf16_t*)(ws + A0_K), (bf16_t*)(ws + A0_VT), p.qg, p.kg,
                        (const float*)(ws + OFF_ROPE));
            }
        } break;
        case 3: if (!PHON(3)) break; attn_phase((const bf16_t*)(ws + A0_Q), (const bf16_t*)(ws + A0_K), (const bf16_t*)(ws + A0_VT), (bf16_t*)(ws + A0_O), p.qg, p.kg, smem); break;
        case 4: if (!PHON(4)) break; {
            GemmArgs ga{(const bf16_t*)(ws + A0_O), nullptr, nullptr, (const bf16_t*)(ws + OFF_AWO), 1024, 1024};
            for (int u = blockIdx.x >> 3, tm, tn; xcd_tile(u, 4, false, tm, tn); u += (G >> 3)) {
                f32x4 acc[2][4][4];
                gemm_main<0, 256>(ga, tm, tn, acc, smem);
                for (int hh = 0; hh < 2; ++hh)
                epi_res(acc[hh], tm * 256 + GEMM_WROW(256) + hh * 64, tn * 256 + GEMM_WCOL(256), lane, p.x, p.ctx, p.out, XC, MOD0, 2, (DBG_ZMASK & 1) ? 0.f : 1.f);
            }
        } break;
        case 5: if (!PHON(5)) break; norm_phase<0>(p.out, XC, p.n2g, MOD0, 3, 4, (bf16_t*)(ws + A0_H), nullptr, false); break;
        case 6: if (!PHON(6)) break; {
            GemmArgs ga{(const bf16_t*)(ws + A0_H), nullptr, nullptr, (const bf16_t*)(ws + OFF_GU), 1024, 1024};
            for (int u = blockIdx.x >> 3, tm, tn; xcd_tile(u, 22, false, tm, tn); u += (G >> 3)) {
                f32x4 acc[2][4][4];
                gemm_main<0, 256>(ga, tm, tn, acc, smem);
                for (int hh = 0; hh < 2; ++hh)
                epi_swiglu(acc[hh], tm * 256 + GEMM_WROW(256) + hh * 64, tn * 256 + GEMM_WCOL(256), lane, (bf16_t*)(ws + A0_ACT));
            }
        } break;
        case 7: if (!PHON(7)) break; {
            GemmArgs ga{(const bf16_t*)(ws + A0_ACT), nullptr, nullptr, (const bf16_t*)(ws + OFF_WD), DFF, DFF};
            for (int u = blockIdx.x >> 3, tm, tn; xcd_tile(u, 4, false, tm, tn); u += (G >> 3)) {
                f32x4 acc[2][4][4];
                gemm_main<0, 256>(ga, tm, tn, acc, smem);
                for (int hh = 0; hh < 2; ++hh)
                epi_res(acc[hh], tm * 256 + GEMM_WROW(256) + hh * 64, tn * 256 + GEMM_WCOL(256), lane, p.out, XC, p.out, XC, MOD0, 5, (DBG_ZMASK & 2) ? 0.f : 1.f);
            }
        } break;
        case 8: if (!PHON(8)) break; norm_phase<1>(p.out, XC, p.n1g + 1024, MOD1, 0, 1, (bf16_t*)(ws + A1_H), (bf16_t*)(ws + A1_XX), false); break;
        case 9: if (!PHON(9)) break; {
            for (int u = blockIdx.x >> 3, tm, r; xcd_tile(u, 12, false, tm, r); u += (G >> 3)) {
                const int jobi = r >> 2, tn = r & 3;
                const int mixrow = jobi == 0 ? 0 : jobi == 1 ? 2 : 3;
                GemmArgs ga{(const bf16_t*)(ws + A1_H), (const bf16_t*)(ws + A1_XX), p.mix + mixrow * 1024,
                            (const bf16_t*)(ws + OFF_WRKV) + (size_t)jobi * 1024 * 1024, 1024, 1024};
                f32x4 acc[2][4][4];
                gemm_main<1, 256>(ga, tm, tn, acc, smem);
                for (int hh = 0; hh < 2; ++hh) {
                    const int row0 = tm * 256 + GEMM_WROW(256) + hh * 64, col0 = tn * 256 + GEMM_WCOL(256);
                    if (jobi == 0) epi_store<0>(acc[hh], row0, col0, lane, (bf16_t*)(ws + A1_R), 1024);
                    else if (jobi == 1) epi_kstore(acc[hh], row0, col0, lane, (bf16_t*)(ws + A1_K), p.k_k, (float*)(ws + OFF_KKN));
                    else epi_store<0>(acc[hh], row0, col0, lane, (bf16_t*)(ws + A1_V), 1024);
                }
            }
            for (int u = ((blockIdx.x >> 3) + 16) & 31, tm, r; xcd_tile(u, 3, false, tm, r); u += (G >> 3)) {
                const int jobi = 3 + r;
                const int mixrow = jobi == 3 ? 1 : jobi == 4 ? 4 : 5;
                GemmArgs ga{(const bf16_t*)(ws + A1_H), (const bf16_t*)(ws + A1_XX), p.mix + mixrow * 1024,
                            (const bf16_t*)(ws + (jobi == 3 ? OFF_W1T : jobi == 4 ? OFF_A1T : OFF_G1T)), 1024, 1024};
                f32x4 acc[1][4][4];
                gemm_main<1, 128>(ga, tm, 0, acc, smem);
                const int row0 = tm * 256 + GEMM_WROW(128), col0 = GEMM_WCOL(128);
                if (jobi == 3) epi_store<1>(acc[0], row0, col0, lane, (bf16_t*)(ws + A1_TW), 128);
                else if (jobi == 4) epi_store<0>(acc[0], row0, col0, lane, (bf16_t*)(ws + A1_TA), 128);
                else epi_store<2>(acc[0], row0, col0, lane, (bf16_t*)(ws + A1_GH), 128);
            }
        } break;
        case 10: if (!PHON(10)) break; scan_phase(p, smem); break;
        case 11: if (!PHON(11)) break; {
            GemmArgs ga{(const bf16_t*)(ws + A1_GH), nullptr, nullptr, (const bf16_t*)(ws + OFF_G2T), 128, 128};
            for (int u = blockIdx.x >> 3, tm, tn; xcd_tile(u, 8, true, tm, tn); u += (G >> 3)) {
                f32x4 acc[1][4][4];
                gemm_main<0, 128>(ga, tm, tn, acc, smem);
                epi_readout(acc[0], tm * 256 + GEMM_WROW(128), tn * 128 + GEMM_WCOL(128), lane, (const bf16_t*)(ws + A1_Y0), (const bf16_t*)(ws + A1_Y1),
                            (const float*)(ws + OFF_BS), (const bf16_t*)(ws + A1_V), p.lng, p.lnb, (bf16_t*)(ws + A1_Z));
            }
        } break;
        case 12: if (!PHON(12)) break; {
            GemmArgs ga{(const bf16_t*)(ws + A1_Z), nullptr, nullptr, (const bf16_t*)(ws + OFF_RWO), 1024, 1024};
            for (int u = blockIdx.x >> 3, tm, tn; xcd_tile(u, 4, true, tm, tn); u += (G >> 3)) {
                f32x4 acc[2][4][4];
                gemm_main<0, 256>(ga, tm, tn, acc, smem);
                for (int hh = 0; hh < 2; ++hh)
                epi_res(acc[hh], tm * 256 + GEMM_WROW(256) + hh * 64, tn * 256 + GEMM_WCOL(256), lane, p.out, XC, p.out, XC, MOD1, 2, (DBG_ZMASK & 4) ? 0.f : 1.f);
            }
        } break;
        case 13: if (!PHON(13)) break; norm_phase<0>(p.out, XC, p.n2g + 1024, MOD1, 3, 4, (bf16_t*)(ws + A1_H2), nullptr, true); break;
        case 14: if (!PHON(14)) break; {
            GemmArgs ga{(const bf16_t*)(ws + A1_H2), nullptr, nullptr, (const bf16_t*)(ws + OFF_GU) + (size_t)5632 * 1024, 1024, 1024};
            for (int u = blockIdx.x >> 3, tm, tn; xcd_tile(u, 22, true, tm, tn); u += (G >> 3)) {
                f32x4 acc[2][4][4];
                gemm_main<0, 256>(ga, tm, tn, acc, smem);
                for (int hh = 0; hh < 2; ++hh)
                epi_swiglu(acc[hh], tm * 256 + GEMM_WROW(256) + hh * 64, tn * 256 + GEMM_WCOL(256), lane, (bf16_t*)(ws + A1_ACT));
            }
        } break;
        case 15: if (!PHON(15)) break; {
            GemmArgs ga{(const bf16_t*)(ws + A1_ACT), nullptr, nullptr, (const bf16_t*)(ws + OFF_WD) + (size_t)1024 * DFF, DFF, DFF};
            for (int u = blockIdx.x >> 3, tm, tn; xcd_tile(u, 4, true, tm, tn); u += (G >> 3)) {
                f32x4 acc[2][4][4];
                gemm_main<0, 256>(ga, tm, tn, acc, smem);
                for (int hh = 0; hh < 2; ++hh)
                epi_res(acc[hh], tm * 256 + GEMM_WROW(256) + hh * 64, tn * 256 + GEMM_WCOL(256), lane, p.out, XC, p.out, XC, MOD1, 5, (DBG_ZMASK & 8) ? 0.f : 1.f);
            }
        } break;
        case 16: if (!PHON(16)) break; final_norm_phase(p.out, p.fg); break;
        default: break;
        }
    }
}


__device__ __forceinline__ void fast_grid_barrier(unsigned* base, unsigned nblocks) {
    __syncthreads();
    if (threadIdx.x == 0) {
        __threadfence();
        const unsigned ngrp = (nblocks & 7u) ? 1u : 8u, grp = (ngrp == 8u) ? (blockIdx.x & 7u) : 0u, per = nblocks / ngrp;
        const unsigned old = __hip_atomic_fetch_add(base + grp * 32, 1u, __ATOMIC_RELAXED, __HIP_MEMORY_SCOPE_AGENT);
        if (old == per - 1) {
            __threadfence();
            __hip_atomic_fetch_add(base + 8 * 32, 1u, __ATOMIC_RELAXED, __HIP_MEMORY_SCOPE_AGENT);
        }
        while (__hip_atomic_load(base + 8 * 32, __ATOMIC_RELAXED, __HIP_MEMORY_SCOPE_AGENT) < ngrp) __builtin_amdgcn_s_sleep(2);
        __threadfence();
    }
    __syncthreads();
}

#define DO_PHASE(n)                                  \
    if (p.plo <= (n) && (n) < p.phi) {               \
        if ((n) > p.plo) fast_grid_barrier((unsigned*)(p.ws + OFF_SYNC) + 512 * (n), gridDim.x); \
        run_phase<n>(p, smem);                       \
    }
__global__ void __launch_bounds__(NTHR) fwd_kernel(Pm p) {
    extern __shared__ __attribute__((aligned(16))) char smem[];
    cg::grid_group grid = cg::this_grid();
    if (p.plo < 0) grid.sync();
    DO_PHASE(0) DO_PHASE(1) DO_PHASE(2) DO_PHASE(3) DO_PHASE(4) DO_PHASE(5) DO_PHASE(6) DO_PHASE(7) DO_PHASE(8)
    DO_PHASE(9) DO_PHASE(10) DO_PHASE(11) DO_PHASE(12) DO_PHASE(13) DO_PHASE(14) DO_PHASE(15) DO_PHASE(16)
}

extern "C" void kernel_launch(void* const* d_in, const int* in_sizes, int n_in, void* d_out, int out_size, void* d_ws, size_t ws_size, hipStream_t stream) {
    Pm p{};
    const float** pp = (const float**)&p;
    for (int i = 0; i < 32; ++i) pp[i] = (const float*)d_in[i];
    p.out = (float*)d_out;
    p.ws = (char*)d_ws;
    if (ws_size < WS_NEED) fprintf(stderr, "workspace too small: %zu < %zu\n", ws_size, (size_t)WS_NEED);
    static int grid_blocks = 0;
    if (!grid_blocks) {
        hipFuncSetAttribute((const void*)fwd_kernel, hipFuncAttributeMaxDynamicSharedMemorySize, LDS_BYTES);
        int dev = 0, cus = 0, per_cu = 0;
        hipGetDevice(&dev);
        hipDeviceGetAttribute(&cus, hipDeviceAttributeMultiprocessorCount, dev);
        hipOccupancyMaxActiveBlocksPerMultiprocessor(&per_cu, fwd_kernel, NTHR, LDS_BYTES);
        if (per_cu < 1) per_cu = 1;
        grid_blocks = cus * per_cu;
    }
    (void)hipMemsetAsync((char*)d_ws + OFF_SYNC, 0, 2048 * 20, stream);
#if MULTI_LAUNCH
    for (int ph = 0; ph < NPHASE; ++ph) {
        p.plo = ph;
        p.phi = ph + 1;
        hipLaunchKernelGGL(fwd_kernel, dim3(grid_blocks), dim3(NTHR), LDS_BYTES, stream, p);
    }
#else
    p.plo = 0;
    p.phi = NPHASE;
    void* args[] = {&p};
    hipError_t e = hipLaunchCooperativeKernel((void*)fwd_kernel, dim3(grid_blocks), dim3(NTHR), args, LDS_BYTES, stream);
    if (e != hipSuccess) fprintf(stderr, "cooperative launch failed: %s (grid %d)\n", hipGetErrorString(e), grid_blocks);
#endif
}
```

```cpp
#include <hip/hip_runtime.h>
#include <hip/hip_cooperative_groups.h>
#include <cstdint>
#include <cstdio>
namespace cg = cooperative_groups;

#ifndef MULTI_LAUNCH
#define MULTI_LAUNCH 0
#endif

typedef unsigned short bf16_t;
typedef short bf16x8 __attribute__((ext_vector_type(8)));
typedef float f32x4 __attribute__((ext_vector_type(4)));

#define NB 8
#define SEQL 8192
#define CTXL 256
#define PB 8448
#define RT (NB * PB)
#define DM 1024
#define DFF 2816
#define NTHR 512

constexpr size_t U = (size_t)RT * 1024 * 2;
constexpr size_t OFF_WQKV = 0;
constexpr size_t OFF_AWO = OFF_WQKV + (size_t)1536 * 1024 * 2;
constexpr size_t OFF_GU = OFF_AWO + (size_t)1024 * 1024 * 2;
constexpr size_t OFF_WD = OFF_GU + (size_t)2 * 5632 * 1024 * 2;
constexpr size_t OFF_WRKV = OFF_WD + (size_t)2 * 1024 * 2816 * 2;
constexpr size_t OFF_W1T = OFF_WRKV + (size_t)3 * 1024 * 1024 * 2;
constexpr size_t OFF_A1T = OFF_W1T + (size_t)128 * 1024 * 2;
constexpr size_t OFF_G1T = OFF_A1T + (size_t)128 * 1024 * 2;
constexpr size_t OFF_W2T = OFF_G1T + (size_t)128 * 1024 * 2;
constexpr size_t OFF_A2T = OFF_W2T + (size_t)2 * 1024 * 64 * 2;
constexpr size_t OFF_G2T = OFF_A2T + (size_t)2 * 1024 * 64 * 2;
constexpr size_t OFF_RWO = OFF_G2T + (size_t)1024 * 128 * 2;
constexpr size_t OFF_MOD = OFF_RWO + (size_t)1024 * 1024 * 2;
constexpr size_t OFF_ROPE = OFF_MOD + (size_t)2 * 9 * 6144 * 4;
constexpr size_t OFF_KKN = OFF_ROPE + (size_t)2 * 128 * 16 * 4;
constexpr size_t OFF_BS = OFF_KKN + (size_t)RT * 16 * 4;
constexpr size_t OFF_XC = OFF_BS + (size_t)2 * RT * 16 * 4;
constexpr size_t OFF_ACTR = OFF_XC + (size_t)NB * CTXL * DM * 4;
constexpr size_t A0_H = OFF_ACTR, A0_Q = A0_H + U, A0_K = A0_Q + U, A0_VT = A0_K + U / 4, A0_O = A0_VT + U / 4, A0_ACT = A0_O + U;
constexpr size_t A1_H = OFF_ACTR, A1_XX = A1_H + U, A1_R = A1_XX + U, A1_K = A1_R + U, A1_V = A1_K + U, A1_TW = A1_V + U, A1_TA = A1_TW + U / 8,
                 A1_GH = A1_TA + U / 8;
constexpr size_t A1_Y0 = OFF_ACTR, A1_Y1 = OFF_ACTR + U, A1_Z = A1_R, A1_H2 = OFF_ACTR, A1_ACT = A1_K;
constexpr size_t WS_NEED = A0_ACT + (size_t)RT * DFF * 2;

constexpr size_t OFF_SYNC = WS_NEED;
constexpr int LDS_BYTES = 2 * (256 + 256) * 72 * 2;

struct Pm {
    const float *x, *c, *ctx, *c_ctx, *mod_w, *mod_b, *n1g, *n2g, *wg, *wu, *wd, *wqkv, *qg, *kg, *awo, *mix, *wrkv, *w0, *w1, *w2, *a0, *a1, *a2, *g1,
        *g2, *k_k, *k_a, *r_k, *lng, *lnb, *rwo, *fg;
    float* out;
    char* ws;
    int plo, phi;
};

typedef __bf16 bf16v2_t __attribute__((ext_vector_type(2)));
typedef float f32v2_t __attribute__((ext_vector_type(2)));
__device__ __forceinline__ unsigned pk2(float lo, float hi) {
    f32v2_t f = {lo, hi};
    bf16v2_t v = __builtin_convertvector(f, bf16v2_t);
    return __builtin_bit_cast(unsigned, v);
}
__device__ __forceinline__ bf16_t f2bf(float f) { return (bf16_t)(pk2(f, 0.f) & 0xffffu); }
__device__ __forceinline__ float bflo(unsigned u) { return __uint_as_float(u << 16); }
__device__ __forceinline__ float bfhi(unsigned u) { return __uint_as_float(u & 0xffff0000u); }
__device__ __forceinline__ void st4bf(bf16_t* p, float a, float b, float c, float d) { *(uint2*)p = make_uint2(pk2(a, b), pk2(c, d)); }
__device__ __forceinline__ void st4bf(bf16_t* p, f32x4 v) { st4bf(p, v[0], v[1], v[2], v[3]); }
__device__ __forceinline__ f32x4 ld4bf(const bf16_t* p) {
    uint2 u = *(const uint2*)p;
    return (f32x4){bflo(u.x), bfhi(u.x), bflo(u.y), bfhi(u.y)};
}
__device__ __forceinline__ float xsum16_32(float v) {
    v += __shfl_xor(v, 16);
    v += __shfl_xor(v, 32);
    return v;
}
__device__ __forceinline__ float xmax16_32(float v) {
    v = fmaxf(v, __shfl_xor(v, 16));
    v = fmaxf(v, __shfl_xor(v, 32));
    return v;
}
__device__ __forceinline__ float wave_sum(float v) {
#pragma unroll
    for (int o = 32; o >= 1; o >>= 1) v += __shfl_xor(v, o);
    return v;
}
__device__ __forceinline__ float fsigmoid(float x) { return __builtin_amdgcn_rcpf(1.0f + __expf(-x)); }
__device__ __forceinline__ float fsilu(float x) { return x * __builtin_amdgcn_rcpf(1.0f + __expf(-x)); }
__device__ __forceinline__ float ftanh(float x) {
    float e = __expf(-2.0f * fabsf(x));
    float t = (1.0f - e) * __builtin_amdgcn_rcpf(1.0f + e);
    return x < 0.f ? -t : t;
}
template <class T> __device__ __forceinline__ T* xrow(T* lat, T* ctxp, int r) {
    int b = r / PB, p = r - b * PB;
    return p < CTXL ? ctxp + (size_t)(b * CTXL + p) * DM : lat + (size_t)(b * SEQL + (p - CTXL)) * DM;
}
__device__ __forceinline__ int modrow(int r) {
    int b = r / PB, p = r - b * PB;
    return p < CTXL ? 8 : b;
}

__device__ __forceinline__ void conv_tile(const float* src, bf16_t* dst, int K, int N, int mode, int roff, int t, float* tl) {
    const int tid = threadIdx.x;
    const int ntn = N >> 6;
    const int tk = t / ntn, tn = t - tk * ntn, k0 = tk * 64, n0 = tn * 64;
    __syncthreads();
#pragma unroll
    for (int i = 0; i < 8; ++i) {
        int k = (tid >> 6) + 8 * i;
        tl[k * 65 + (tid & 63)] = src[(size_t)(k0 + k) * N + n0 + (tid & 63)];
    }
    __syncthreads();
#pragma unroll
    for (int i = 0; i < 4; ++i) {
        int n = (tid >> 5) + 16 * i, ng = n0 + n, kp = (tid & 31) * 2;
        int drow = mode ? ((ng >> 4) * 32 + (ng & 15) + roff) : (ng + roff);
        *(unsigned*)(dst + (size_t)drow * K + k0 + kp) = pk2(tl[kp * 65 + n], tl[(kp + 1) * 65 + n]);
    }
}

__device__ void phase0(const Pm& p, char* smem) {
    const int tid = threadIdx.x, G = gridDim.x;
    char* ws = p.ws;
    float* fl = (float*)smem;
    if (blockIdx.x < 192) {
        float* s = fl;
        float* red = fl + 9 * 1024;
        for (int idx = tid; idx < 9 * 1024; idx += NTHR) {
            int r = idx >> 10, k = idx & 1023;
            float v = r < 8 ? p.c[r * 1024 + k] : p.c_ctx[k];
            s[idx] = fsilu(v);
        }
        __syncthreads();
        for (int it = blockIdx.x; it < 192; it += G) {
            const int l = it / 96, q = it - l * 96;
            const int col = q * 64 + (tid & 63), kg = tid >> 6;
            const float* wp = p.mod_w + (size_t)l * 1024 * 6144 + col;
            float acc[9];
#pragma unroll
            for (int r = 0; r < 9; ++r) acc[r] = 0.f;
#pragma unroll 8
            for (int kk = 0; kk < 128; ++kk) {
                int k = kg * 128 + kk;
                float w = wp[(size_t)k * 6144];
#pragma unroll
                for (int r = 0; r < 9; ++r) acc[r] += s[r * 1024 + k] * w;
            }
#pragma unroll
            for (int r = 0; r < 9; ++r) red[(kg * 9 + r) * 64 + (tid & 63)] = acc[r];
            __syncthreads();
            for (int idx = tid; idx < 9 * 64; idx += NTHR) {
                int r = idx >> 6, cc = idx & 63;
                float v = 0.f;
#pragma unroll
                for (int g8 = 0; g8 < 8; ++g8) v += red[(g8 * 9 + r) * 64 + cc];
                int cg_ = q * 64 + cc;
                ((float*)(ws + OFF_MOD))[((size_t)l * 9 + r) * 6144 + cg_] = v + p.mod_b[l * 6144 + cg_];
            }
            __syncthreads();
        }
    }
    if (blockIdx.x == G - 1) {
        float* rt = (float*)(ws + OFF_ROPE);
        for (int idx = tid; idx < 2048; idx += NTHR) {
            int pos = idx >> 4, pi = idx & 15;
            float inv = powf(10000.0f, -(float)pi / 16.0f);
            float ang = (float)pos * inv;
            rt[idx] = cosf(ang);
            rt[2048 + idx] = sinf(ang);
        }
    }
    int cur = blockIdx.x, base = 0;
    auto job = [&](const float* src, bf16_t* dst, int K, int N, int mode, int roff) {
        int n = (K >> 6) * (N >> 6);
        while (cur < base + n) {
            conv_tile(src, dst, K, N, mode, roff, cur - base, fl);
            cur += G;
        }
        base += n;
    };
    job(p.wqkv, (bf16_t*)(ws + OFF_WQKV), 1024, 1536, 0, 0);
    job(p.awo, (bf16_t*)(ws + OFF_AWO), 1024, 1024, 0, 0);
    for (int l = 0; l < 2; ++l) {
        job(p.wg + (size_t)l * 1024 * DFF, (bf16_t*)(ws + OFF_GU) + (size_t)l * 5632 * 1024, 1024, DFF, 1, 0);
        job(p.wu + (size_t)l * 1024 * DFF, (bf16_t*)(ws + OFF_GU) + (size_t)l * 5632 * 1024, 1024, DFF, 1, 16);
        job(p.wd + (size_t)l * DFF * 1024, (bf16_t*)(ws + OFF_WD) + (size_t)l * 1024 * DFF, DFF, 1024, 0, 0);
    }
    for (int j = 0; j < 3; ++j) job(p.wrkv + (size_t)j * 1024 * 1024, (bf16_t*)(ws + OFF_WRKV) + (size_t)j * 1024 * 1024, 1024, 1024, 0, 0);
    for (int d = 0; d < 2; ++d) {
        job(p.w1 + (size_t)d * 1024 * 64, (bf16_t*)(ws + OFF_W1T), 1024, 64, 0, d * 64);
        job(p.a1 + (size_t)d * 1024 * 64, (bf16_t*)(ws + OFF_A1T), 1024, 64, 0, d * 64);
        job(p.w2 + (size_t)d * 64 * 1024, (bf16_t*)(ws + OFF_W2T) + (size_t)d * 1024 * 64, 64, 1024, 0, 0);
        job(p.a2 + (size_t)d * 64 * 1024, (bf16_t*)(ws + OFF_A2T) + (size_t)d * 1024 * 64, 64, 1024, 0, 0);
    }
    job(p.g1, (bf16_t*)(ws + OFF_G1T), 1024, 128, 0, 0);
    job(p.g2, (bf16_t*)(ws + OFF_G2T), 128, 1024, 0, 0);
    job(p.rwo, (bf16_t*)(ws + OFF_RWO), 1024, 1024, 0, 0);
}

__device__ __forceinline__ void norm_row(const float* xr, const float* g, const float* msh, const float* msc, f32x4 (&h)[4], int lane) {
    f32x4 v[4];
    float ss = 0.f;
#pragma unroll
    for (int i = 0; i < 4; ++i) {
        v[i] = *(const f32x4*)(xr + lane * 4 + i * 256);
        ss += v[i][0] * v[i][0] + v[i][1] * v[i][1] + v[i][2] * v[i][2] + v[i][3] * v[i][3];
    }
    ss = wave_sum(ss);
    const float rstd = rsqrtf(ss * (1.0f / 1024.0f) + 1e-6f);
#pragma unroll
    for (int i = 0; i < 4; ++i) {
        f32x4 gg = *(const f32x4*)(g + lane * 4 + i * 256);
        f32x4 sh = *(const f32x4*)(msh + lane * 4 + i * 256);
        f32x4 sc = *(const f32x4*)(msc + lane * 4 + i * 256);
        h[i] = (v[i] * rstd) * gg * (sc + 1.0f) + sh;
    }
}

template <int SHIFT>
__device__ void norm_phase(const float* lat, const float* ctxp, const float* g, const float* modl, int shI, int scI, bf16_t* H, bf16_t* XX, bool lat_only) {
    const int lane = threadIdx.x & 63, w = threadIdx.x >> 6;
    const int nw = gridDim.x * 8;
    if (SHIFT) {
        for (int grp = blockIdx.x * 8 + w; grp < RT / 4; grp += nw) {
            const int row0 = grp * 4, b = row0 / PB, pp0 = row0 - b * PB;
            const int mr = pp0 < CTXL ? 8 : b;
            const float* msh = modl + (size_t)mr * 6144 + shI * 1024;
            const float* msc = modl + (size_t)mr * 6144 + scI * 1024;
            const bool hasP = !(pp0 == 0 || pp0 == CTXL), hasN = !(pp0 + 3 == CTXL - 1 || pp0 + 3 == PB - 1);
            f32x4 hprev[4], hcur[4], hnext[4];
            if (hasP) norm_row(xrow(lat, ctxp, row0 - 1), g, msh, msc, hprev, lane);
            else {
#pragma unroll
                for (int i = 0; i < 4; ++i) hprev[i] = (f32x4){0.f, 0.f, 0.f, 0.f};
            }
            norm_row(xrow(lat, ctxp, row0), g, msh, msc, hcur, lane);
#pragma unroll
            for (int r = 0; r < 4; ++r) {
                const int row = row0 + r;
                if (r < 3 || hasN) norm_row(xrow(lat, ctxp, row + 1), g, msh, msc, hnext, lane);
                else {
#pragma unroll
                    for (int i = 0; i < 4; ++i) hnext[i] = (f32x4){0.f, 0.f, 0.f, 0.f};
                }
#pragma unroll
                for (int i = 0; i < 4; ++i) {
                    st4bf(H + (size_t)row * DM + lane * 4 + i * 256, hcur[i]);
                    st4bf(XX + (size_t)row * DM + lane * 4 + i * 256, (hprev[i] + hnext[i]) * 0.5f - hcur[i]);
                    hprev[i] = hcur[i];
                    hcur[i] = hnext[i];
                }
            }
        }
        return;
    }
    for (int row = blockIdx.x * 8 + w; row < RT; row += nw) {
        const int b = row / PB, pp = row - b * PB;
        if (lat_only && pp < CTXL) continue;
        const int mr = pp < CTXL ? 8 : b;
        const float* msh = modl + (size_t)mr * 6144 + shI * 1024;
        const float* msc = modl + (size_t)mr * 6144 + scI * 1024;
        f32x4 h[4];
        norm_row(xrow(lat, ctxp, row), g, msh, msc, h, lane);
#pragma unroll
        for (int i = 0; i < 4; ++i) st4bf(H + (size_t)row * DM + lane * 4 + i * 256, h[i]);
        if (SHIFT) {
            f32x4 hp[4], hn[4];
            const bool hasP = !(pp == 0 || pp == CTXL), hasN = !(pp == CTXL - 1 || pp == PB - 1);
            if (hasP) norm_row(xrow(lat, ctxp, row - 1), g, msh, msc, hp, lane);
            else {
#pragma unroll
                for (int i = 0; i < 4; ++i) hp[i] = (f32x4){0.f, 0.f, 0.f, 0.f};
            }
            if (hasN) norm_row(xrow(lat, ctxp, row + 1), g, msh, msc, hn, lane);
            else {
#pragma unroll
                for (int i = 0; i < 4; ++i) hn[i] = (f32x4){0.f, 0.f, 0.f, 0.f};
            }
#pragma unroll
            for (int i = 0; i < 4; ++i) st4bf(XX + (size_t)row * DM + lane * 4 + i * 256, (hp[i] + hn[i]) * 0.5f - h[i]);
        }
    }
}

__device__ void final_norm_phase(float* X, const float* g) {
    const int lane = threadIdx.x & 63, w = threadIdx.x >> 6;
    const int nw = gridDim.x * 8;
    for (int row = blockIdx.x * 8 + w; row < NB * SEQL; row += nw) {
        float* xr = X + (size_t)row * DM;
        f32x4 v[4];
        float ss = 0.f;
#pragma unroll
        for (int i = 0; i < 4; ++i) {
            v[i] = *(const f32x4*)(xr + lane * 4 + i * 256);
            ss += v[i][0] * v[i][0] + v[i][1] * v[i][1] + v[i][2] * v[i][2] + v[i][3] * v[i][3];
        }
        ss = wave_sum(ss);
        const float rstd = rsqrtf(ss * (1.0f / 1024.0f) + 1e-6f);
#pragma unroll
        for (int i = 0; i < 4; ++i) {
            f32x4 gg = *(const f32x4*)(g + lane * 4 + i * 256);
            *(f32x4*)(xr + lane * 4 + i * 256) = (v[i] * rstd) * gg;
        }
    }
}

struct GemmArgs {
    const bf16_t* A;
    const bf16_t* A2;
    const float* mix;
    const bf16_t* Bt;
    int K, lda;
};

template <int AMODE, int BN>
__device__ __forceinline__ void gemm_main(const GemmArgs g, int tm, int tn, f32x4 (&acc)[BN / 128][4][4], char* smem) {
    constexpr int MT = BN / 128;
    const bf16_t* const gA = g.A; const bf16_t* const gA2 = g.A2; const float* const gmix = g.mix; const bf16_t* const gBt = g.Bt; const int lda = g.lda;
    const int tid = threadIdx.x, lane = tid & 63, w = tid >> 6;
    const int wr = (BN == 256) ? (w >> 2) : (w >> 1), wc = (BN == 256) ? (w & 3) : (w & 1), fr = lane & 15, fq = lane >> 4;
    bf16_t* As = (bf16_t*)smem;
    bf16_t* Bs = As + 2 * 256 * 72;
    const int K = g.K, nk = K >> 6;
#pragma unroll
    for (int h = 0; h < MT; ++h)
#pragma unroll
        for (int mi = 0; mi < 4; ++mi)
#pragma unroll
            for (int ni = 0; ni < 4; ++ni) acc[h][mi][ni] = (f32x4){0.f, 0.f, 0.f, 0.f};
    uint4 ra0, ra1, ra2, ra3;
#define rb0 ra0
#define rb1 ra1
#define rb2 ra2
#define rb3 ra3
    const int arow = tid >> 3, akc = (tid & 7) * 8;
    const bf16_t* Ap = gA + (size_t)(tm * 256 + arow) * lda + akc;
    const bf16_t* A2p = AMODE ? gA2 + (size_t)(tm * 256 + arow) * lda + akc : nullptr;
    const bf16_t* Bp = gBt + (size_t)(tn * BN + arow) * K + akc;
#define GLOAD_A(R, I, KT)                                                                                         \
    {                                                                                                             \
        uint4 hv = *(const uint4*)(Ap + (size_t)(I) * 64 * lda + (KT) * 64);                                      \
        if (AMODE) {                                                                                              \
            uint4 xv = *(const uint4*)(A2p + (size_t)(I) * 64 * lda + (KT) * 64);                                 \
            f32x4 m0 = *(const f32x4*)(gmix + (KT) * 64 + akc), m1 = *(const f32x4*)(gmix + (KT) * 64 + akc + 4); \
            hv.x = pk2(bflo(hv.x) + bflo(xv.x) * m0[0], bfhi(hv.x) + bfhi(xv.x) * m0[1]);                         \
            hv.y = pk2(bflo(hv.y) + bflo(xv.y) * m0[2], bfhi(hv.y) + bfhi(xv.y) * m0[3]);                         \
            hv.z = pk2(bflo(hv.z) + bflo(xv.z) * m1[0], bfhi(hv.z) + bfhi(xv.z) * m1[1]);                         \
            hv.w = pk2(bflo(hv.w) + bflo(xv.w) * m1[2], bfhi(hv.w) + bfhi(xv.w) * m1[3]);                         \
        }                                                                                                         \
        R = hv;                                                                                                   \
    }
#define GLOAD_AALL(KT) GLOAD_A(ra0, 0, KT) GLOAD_A(ra1, 1, KT) GLOAD_A(ra2, 2, KT) GLOAD_A(ra3, 3, KT)
#define GLOAD_BALL(KT)                                                                \
    rb0 = *(const uint4*)(Bp + (KT) * 64);                                            \
    rb1 = *(const uint4*)(Bp + (size_t)64 * K + (KT) * 64);                           \
    if (BN == 256) {                                                                  \
        rb2 = *(const uint4*)(Bp + (size_t)128 * K + (KT) * 64);                      \
        rb3 = *(const uint4*)(Bp + (size_t)192 * K + (KT) * 64);                      \
    }
#define LSTORE_A(BUF)                                                                \
    {                                                                                \
        bf16_t* a_ = As + (size_t)(BUF) * 256 * 72 + arow * 72 + akc;                \
        *(uint4*)(a_) = ra0;                                                         \
        *(uint4*)(a_ + 64 * 72) = ra1;                                               \
        *(uint4*)(a_ + 128 * 72) = ra2;                                              \
        *(uint4*)(a_ + 192 * 72) = ra3;                                              \
    }
#define LSTORE_B(BUF)                                                                \
    {                                                                                \
        bf16_t* b_ = Bs + (size_t)(BUF) * BN * 72 + arow * 72 + akc;                 \
        *(uint4*)(b_) = rb0;                                                         \
        *(uint4*)(b_ + 64 * 72) = rb1;                                               \
        if (BN == 256) {                                                             \
            *(uint4*)(b_ + 128 * 72) = rb2;                                          \
            *(uint4*)(b_ + 192 * 72) = rb3;                                          \
        }                                                                            \
    }
#define GEMM_KS(ks)                                                                                                                 \
    {                                                                                                                               \
        bf16x8 bf[4];                                                                                                               \
        _Pragma("unroll") for (int ni = 0; ni < 4; ++ni) bf[ni] = *(const bf16x8*)(Bb + ni * 16 * 72 + (ks) * 32);                  \
        _Pragma("unroll") for (int h = 0; h < MT; ++h) {                                                                            \
            bf16x8 af[4];                                                                                                           \
            _Pragma("unroll") for (int mi = 0; mi < 4; ++mi) af[mi] = *(const bf16x8*)(Ab + (h * 64 + mi * 16) * 72 + (ks) * 32);   \
            __builtin_amdgcn_s_setprio(1);                                                                                          \
            _Pragma("unroll") for (int mi = 0; mi < 4; ++mi)                                                                        \
                _Pragma("unroll") for (int ni = 0; ni < 4; ++ni)                                                                    \
                    acc[h][mi][ni] = __builtin_amdgcn_mfma_f32_16x16x32_bf16(bf[ni], af[mi], acc[h][mi][ni], 0, 0, 0);              \
            __builtin_amdgcn_s_setprio(0);                                                                                          \
        }                                                                                                                           \
    }
    {
        GLOAD_AALL(0)
        __syncthreads();
        LSTORE_A(0)
    }
    {
        GLOAD_BALL(0)
        LSTORE_B(0)
    }
    __syncthreads();
    for (int kt = 0; kt < nk; ++kt) {
        const int cur = kt & 1;
        const bool nxt = kt + 1 < nk;
        const bf16_t* Ab = As + (size_t)cur * 256 * 72 + (wr * 64 * MT + fr) * 72 + fq * 8;
        const bf16_t* Bb = Bs + (size_t)cur * BN * 72 + (wc * 64 + fr) * 72 + fq * 8;
        if (nxt) { GLOAD_AALL(kt + 1) }
        GEMM_KS(0)
        if (nxt) { LSTORE_A(cur ^ 1) GLOAD_BALL(kt + 1) }
        GEMM_KS(1)
        if (nxt) LSTORE_B(cur ^ 1)
        __syncthreads();
    }
}
#define GEMM_WROW(BN_) ((BN_) == 256 ? ((tid_l >> 8) * 128) : ((tid_l >> 7) * 64))
#define GEMM_WCOL(BN_) ((BN_) == 256 ? (((tid_l >> 6) & 3) * 64) : (((tid_l >> 6) & 1) * 64))


__device__ __forceinline__ bool xcd_tile(int u, int ntn, bool lat_only, int& tm, int& tn) {
    const int x = blockIdx.x & 7;
    const int np = lat_only ? 32 : 33, p0 = lat_only ? 1 : 0;
    if (u >= np * ntn) return false;
    const int g = u / (4 * ntn), v = u - g * 4 * ntn;
    const int gsz = (np - 4 * g) < 4 ? (np - 4 * g) : 4;
    tn = v / gsz;
    tm = 33 * x + p0 + 4 * g + (v - tn * gsz);
    return true;
}

__device__ __forceinline__ void epi_qkv(f32x4 (&acc)[4][4], int row0, int col0, int lane, bf16_t* Q, bf16_t* Kx, bf16_t* VT, const float* qg, const float* kg,
                                        const float* rope) {
    const int fr = lane & 15, fq = lane >> 4;
    if (col0 >= 1280) {
        const int kvh = (col0 - 1280) >> 6;
#pragma unroll
        for (int mi = 0; mi < 4; ++mi) {
            const int row = row0 + mi * 16 + fr, b = row / PB, pp = row - b * PB;
            bf16_t* vb = VT + ((size_t)(b * 4 + kvh) * 64) * PB + pp;
#pragma unroll
            for (int ni = 0; ni < 4; ++ni)
#pragma unroll
                for (int j = 0; j < 4; ++j) vb[(size_t)(ni * 16 + fq * 4 + j) * PB] = f2bf(acc[mi][ni][j]);
        }
        return;
    }
    const bool isq = col0 < 1024;
    const float* gain = isq ? qg : kg;
#pragma unroll
    for (int mi = 0; mi < 4; ++mi) {
        float ss = 0.f;
#pragma unroll
        for (int ni = 0; ni < 4; ++ni)
#pragma unroll
            for (int j = 0; j < 4; ++j) ss += acc[mi][ni][j] * acc[mi][ni][j];
        ss = xsum16_32(ss);
        const float rstd = rsqrtf(ss * (1.0f / 64.0f) + 1e-6f);
        f32x4 v[4];
#pragma unroll
        for (int ni = 0; ni < 4; ++ni) v[ni] = (acc[mi][ni] * rstd) * *(const f32x4*)(gain + ni * 16 + fq * 4);
        const int row = row0 + mi * 16 + fr, b = row / PB, pp = row - b * PB;
        if (pp >= CTXL) {
            const int l = pp - CTXL, prow = l >> 6, pcol = l & 63;
#pragma unroll
            for (int a = 0; a < 2; ++a) {
                const int pos = a ? pcol : prow;
                f32x4 cs = *(const f32x4*)(rope + pos * 16 + fq * 4), sn = *(const f32x4*)(rope + 2048 + pos * 16 + fq * 4);
                f32x4 x1 = v[2 * a], x2 = v[2 * a + 1];
                v[2 * a] = x1 * cs - x2 * sn;
                v[2 * a + 1] = x1 * sn + x2 * cs;
            }
        }
        if (isq) {
#pragma unroll
            for (int ni = 0; ni < 4; ++ni) st4bf(Q + (size_t)row * 1024 + col0 + ni * 16 + fq * 4, v[ni] * (0.125f * 1.44269504088896f));
        } else {
#pragma unroll
            for (int ni = 0; ni < 4; ++ni) st4bf(Kx + (size_t)row * 256 + (col0 - 1024) + ni * 16 + fq * 4, v[ni]);
        }
    }
}

__device__ __forceinline__ void epi_res(f32x4 (&acc)[4][4], int row0, int col0, int lane, const float* slat, const float* sctx, float* dlat, float* dctx,
                                        const float* modl, int gI, float dbg_scale = 1.0f) {
    const int fr = lane & 15, fq = lane >> 4;
#pragma unroll
    for (int mi = 0; mi < 4; ++mi) {
        const int row = row0 + mi * 16 + fr;
        const float* sp = xrow(slat, sctx, row);
        float* dp = xrow(dlat, dctx, row);
        const float* gp = modl + (size_t)modrow(row) * 6144 + gI * 1024;
#pragma unroll
        for (int ni = 0; ni < 4; ++ni) {
            const int col = col0 + ni * 16 + fq * 4;
            f32x4 s = *(const f32x4*)(sp + col), gt = *(const f32x4*)(gp + col);
            f32x4 av = acc[mi][ni];
#ifdef DBG_CLAMPY
            for (int j = 0; j < 4; ++j) av[j] = fminf(fmaxf(av[j], -1.f), 1.f);
#endif
#ifdef DBG_CLAMPG
            for (int j = 0; j < 4; ++j) gt[j] = fminf(fmaxf(gt[j], -1.f), 1.f);
#endif
            *(f32x4*)(dp + col) = s + gt * av * dbg_scale;
        }
    }
}

__device__ __forceinline__ void epi_swiglu(f32x4 (&acc)[4][4], int row0, int col0, int lane, bf16_t* ACT) {
    const int fr = lane & 15, fq = lane >> 4;
#pragma unroll
    for (int mi = 0; mi < 4; ++mi) {
        const int row = row0 + mi * 16 + fr;
#pragma unroll
        for (int h2 = 0; h2 < 2; ++h2) {
            f32x4 gt = acc[mi][2 * h2], up = acc[mi][2 * h2 + 1], o;
#pragma unroll
            for (int j = 0; j < 4; ++j) o[j] = fsilu(gt[j]) * up[j];
            st4bf(ACT + (size_t)row * DFF + (col0 >> 1) + h2 * 16 + fq * 4, o);
        }
    }
}

template <int ACTF>
__device__ __forceinline__ void epi_store(f32x4 (&acc)[4][4], int row0, int col0, int lane, bf16_t* O, int ldo) {
    const int fr = lane & 15, fq = lane >> 4;
#pragma unroll
    for (int mi = 0; mi < 4; ++mi) {
        const int row = row0 + mi * 16 + fr;
#pragma unroll
        for (int ni = 0; ni < 4; ++ni) {
            f32x4 v = acc[mi][ni];
            if (ACTF == 1) {
#pragma unroll
                for (int j = 0; j < 4; ++j) v[j] = ftanh(v[j]);
            }
            if (ACTF == 2) {
#pragma unroll
                for (int j = 0; j < 4; ++j) v[j] = fsigmoid(v[j]);
            }
            st4bf(O + (size_t)row * ldo + col0 + ni * 16 + fq * 4, v);
        }
    }
}

__device__ __forceinline__ void epi_kstore(f32x4 (&acc)[4][4], int row0, int col0, int lane, bf16_t* O, const float* k_k, float* KKN) {
    const int fr = lane & 15, fq = lane >> 4;
    f32x4 kkv[4];
#pragma unroll
    for (int ni = 0; ni < 4; ++ni) kkv[ni] = *(const f32x4*)(k_k + col0 + ni * 16 + fq * 4);
#pragma unroll
    for (int mi = 0; mi < 4; ++mi) {
        const int row = row0 + mi * 16 + fr;
        float ss = 0.f;
#pragma unroll
        for (int ni = 0; ni < 4; ++ni) {
            f32x4 t = acc[mi][ni] * kkv[ni];
            ss += t[0] * t[0] + t[1] * t[1] + t[2] * t[2] + t[3] * t[3];
            st4bf(O + (size_t)row * 1024 + col0 + ni * 16 + fq * 4, acc[mi][ni]);
        }
        ss = xsum16_32(ss);
        if (fq == 0) KKN[(size_t)row * 16 + (col0 >> 6)] = rsqrtf(fmaxf(ss, 1e-24f));
    }
}

__device__ __forceinline__ void epi_readout(f32x4 (&acc)[4][4], int row0, int col0, int lane, const bf16_t* Y0, const bf16_t* Y1, const float* BS, const bf16_t* V,
                                            const float* lng, const float* lnb, bf16_t* Z) {
    const int fr = lane & 15, fq = lane >> 4, hd = col0 >> 6;
    f32x4 lg[4], lb[4];
#pragma unroll
    for (int ni = 0; ni < 4; ++ni) {
        lg[ni] = *(const f32x4*)(lng + col0 + ni * 16 + fq * 4);
        lb[ni] = *(const f32x4*)(lnb + col0 + ni * 16 + fq * 4);
    }
#pragma unroll
    for (int mi = 0; mi < 4; ++mi) {
        const int row = row0 + mi * 16 + fr, b = row / PB, pp = row - b * PB;
        const size_t li = (size_t)b * SEQL + (pp - CTXL);
        f32x4 wk[4];
        float s = 0.f;
#pragma unroll
        for (int ni = 0; ni < 4; ++ni) {
            const int col = col0 + ni * 16 + fq * 4;
            wk[ni] = ld4bf(Y0 + li * 1024 + col) + ld4bf(Y1 + li * 1024 + col);
            s += wk[ni][0] + wk[ni][1] + wk[ni][2] + wk[ni][3];
        }
        s = xsum16_32(s);
        const float mu = s * (1.0f / 64.0f);
        float q = 0.f;
#pragma unroll
        for (int ni = 0; ni < 4; ++ni) {
            wk[ni] = wk[ni] - mu;
            q += wk[ni][0] * wk[ni][0] + wk[ni][1] * wk[ni][1] + wk[ni][2] * wk[ni][2] + wk[ni][3] * wk[ni][3];
        }
        q = xsum16_32(q);
        const float rstd = rsqrtf(q * (1.0f / 64.0f) + 64e-5f);
        const float bsv = BS[(size_t)row * 16 + hd] + BS[(size_t)RT * 16 + (size_t)row * 16 + hd];
#pragma unroll
        for (int ni = 0; ni < 4; ++ni) {
            const int col = col0 + ni * 16 + fq * 4;
            f32x4 vv = ld4bf(V + (size_t)row * 1024 + col);
            f32x4 z = ((wk[ni] * rstd) * lg[ni] + lb[ni] + vv * bsv) * acc[mi][ni];
            st4bf(Z + (size_t)row * 1024 + col, z);
        }
    }
}

__device__ void attn_phase(const bf16_t* Q, const bf16_t* Kx, const bf16_t* VT, bf16_t* O, const float* qg, const float* kg, char* smem) {
    const int tid = threadIdx.x, lane = tid & 63, w = tid >> 6, fr = lane & 15, fq = lane >> 4;
    bf16_t* Ks = (bf16_t*)smem;
    bf16_t* Vs = Ks + 2 * 64 * 72;
    const int xcd = blockIdx.x & 7, slot = blockIdx.x >> 3, nslots = gridDim.x >> 3;
    float gqm = 0.f, gkm = 0.f;
    for (int d = 0; d < 64; ++d) { gqm = fmaxf(gqm, fabsf(qg[d])); gkm = fmaxf(gkm, fabsf(kg[d])); }
    const float mfix = 8.0f * gqm * gkm * 1.44269504088896f * 1.0001f;
    const int lrow = tid >> 3, lch = (tid & 7) * 8;
    for (int it = slot; it < 528; it += nslots) {
        int pr, g, qb;
        if (it < 512) { pr = it >> 7; g = (it >> 5) & 3; qb = 1 + (it & 31); }
        else { const int li = it - 512; pr = li >> 2; g = li & 3; qb = 0; }
        const int pair = xcd + 8 * pr, b = pair >> 2, kvh = pair & 3, hq = kvh * 4 + g;
        const int nt = (qb == 0 ? CTXL : PB) >> 6;
        const int rowbase = b * PB + qb * 256 + w * 32;
        bf16x8 qf[2][2];
#pragma unroll
        for (int qt = 0; qt < 2; ++qt)
#pragma unroll
            for (int ks = 0; ks < 2; ++ks) qf[qt][ks] = *(const bf16x8*)(Q + (size_t)(rowbase + qt * 16 + fr) * 1024 + hq * 64 + ks * 32 + fq * 8);
        const bf16_t* kp = Kx + (size_t)(b * PB + lrow) * 256 + kvh * 64 + lch;
        const bf16_t* vp = VT + ((size_t)(b * 4 + kvh) * 64 + lrow) * PB + lch;
        f32x4 Oa[4][2];
#pragma unroll
        for (int dt = 0; dt < 4; ++dt)
#pragma unroll
            for (int qt = 0; qt < 2; ++qt) Oa[dt][qt] = (f32x4){0.f, 0.f, 0.f, 0.f};
        f32x4 Ol[2] = {(f32x4){0.f, 0.f, 0.f, 0.f}, (f32x4){0.f, 0.f, 0.f, 0.f}};
        uint4 rk = *(const uint4*)kp, rv = *(const uint4*)vp;
        __syncthreads();
        *(uint4*)(Ks + lrow * 72 + lch) = rk;
        *(uint4*)(Vs + lrow * 72 + lch) = rv;
        __syncthreads();
        for (int t = 0; t < nt; ++t) {
            const int cur = t & 1;
            if (t + 1 < nt) {
                kp += 64 * 256;
                vp += 64;
                rk = *(const uint4*)kp;
                rv = *(const uint4*)vp;
            }
            const bf16_t* Kb = Ks + cur * 64 * 72;
            const bf16_t* Vb = Vs + cur * 64 * 72;
            f32x4 S[2][4];
#pragma unroll
            for (int kt = 0; kt < 4; ++kt) {
                bf16x8 k0 = *(const bf16x8*)(Kb + (kt * 16 + fr) * 72 + fq * 8), k1 = *(const bf16x8*)(Kb + (kt * 16 + fr) * 72 + 32 + fq * 8);
#pragma unroll
                for (int qt = 0; qt < 2; ++qt) {
                    f32x4 z = (f32x4){-mfix, -mfix, -mfix, -mfix};
                    z = __builtin_amdgcn_mfma_f32_16x16x32_bf16(k0, qf[qt][0], z, 0, 0, 0);
                    S[qt][kt] = __builtin_amdgcn_mfma_f32_16x16x32_bf16(k1, qf[qt][1], z, 0, 0, 0);
                }
            }
            bf16x8 pf[2][2];
#pragma unroll
            for (int qt = 0; qt < 2; ++qt) {
#pragma unroll
                for (int kt = 0; kt < 4; ++kt) {
                    f32x4 e = S[qt][kt];
#pragma unroll
                    for (int j = 0; j < 4; ++j) e[j] = __builtin_amdgcn_exp2f(e[j]);
                    S[qt][kt] = e;
                }
#pragma unroll
                for (int s2 = 0; s2 < 2; ++s2) {
                    uint4 u;
                    u.x = pk2(S[qt][2 * s2][0], S[qt][2 * s2][1]);
                    u.y = pk2(S[qt][2 * s2][2], S[qt][2 * s2][3]);
                    u.z = pk2(S[qt][2 * s2 + 1][0], S[qt][2 * s2 + 1][1]);
                    u.w = pk2(S[qt][2 * s2 + 1][2], S[qt][2 * s2 + 1][3]);
                    pf[qt][s2] = __builtin_bit_cast(bf16x8, u);
                }
            }
            {
                const uint4 uo = make_uint4(0x3f803f80u, 0x3f803f80u, 0x3f803f80u, 0x3f803f80u);
                const bf16x8 vones = __builtin_bit_cast(bf16x8, uo);
#pragma unroll
                for (int s2 = 0; s2 < 2; ++s2)
#pragma unroll
                    for (int qt = 0; qt < 2; ++qt) Ol[qt] = __builtin_amdgcn_mfma_f32_16x16x32_bf16(vones, pf[qt][s2], Ol[qt], 0, 0, 0);
            }
#pragma unroll
            for (int dt = 0; dt < 4; ++dt)
#pragma unroll
                for (int s2 = 0; s2 < 2; ++s2) {
                    uint2 v0 = *(const uint2*)(Vb + (dt * 16 + fr) * 72 + s2 * 32 + fq * 4), v1 = *(const uint2*)(Vb + (dt * 16 + fr) * 72 + s2 * 32 + 16 + fq * 4);
                    uint4 u = make_uint4(v0.x, v0.y, v1.x, v1.y);
                    bf16x8 vf = __builtin_bit_cast(bf16x8, u);
#pragma unroll
                    for (int qt = 0; qt < 2; ++qt) Oa[dt][qt] = __builtin_amdgcn_mfma_f32_16x16x32_bf16(vf, pf[qt][s2], Oa[dt][qt], 0, 0, 0);
                }
            if (t + 1 < nt) {
                *(uint4*)(Ks + (cur ^ 1) * 64 * 72 + lrow * 72 + lch) = rk;
                *(uint4*)(Vs + (cur ^ 1) * 64 * 72 + lrow * 72 + lch) = rv;
            }
            __syncthreads();
        }
#pragma unroll
        for (int qt = 0; qt < 2; ++qt) {
            const float inv = 1.0f / Ol[qt][0];
            bf16_t* op = O + (size_t)(rowbase + qt * 16 + fr) * 1024 + hq * 64 + fq * 4;
#pragma unroll
            for (int dt = 0; dt < 4; ++dt) {
                f32x4 ov = Oa[dt][qt] * inv;
#ifdef DBG_CLAMPO
                for (int j = 0; j < 4; ++j) ov[j] = fminf(fmaxf(ov[j], -8.f), 8.f);
#endif
                st4bf(op + dt * 16, ov);
            }
        }
    }
}

#define DPPB(J) " row_newbcast:" #J " row_mask:0xf bank_mask:0xf bound_ctrl:1"
#define FMAC_BC(ACC, X, Y, J) asm volatile("v_fmac_f32_dpp %0, %1, %2" DPPB(J) : "+v"(ACC) : "v"(X), "v"(Y))
#define MUL_BC(D, X, Y, J) asm volatile("v_mul_f32_dpp %0, %1, %2" DPPB(J) : "=v"(D) : "v"(X), "v"(Y))
#define SCAN_J(J)                                  \
    MUL_BC(S[J], wv, S[J], J);                     \
    FMAC_BC(S[J], bv, sa, J);                      \
    FMAC_BC(S[J], kdv, vv, J);
#define R1_J(A, J) FMAC_BC(A, unv, S[J], J);
#define UPD_J(J)                                   \
    FMAC_BC(S[J], bv, sa, J);                      \
    FMAC_BC(S[J], kdv, vv, J);
#define RSC_J(J) MUL_BC(S[J], dl, S[J], J);
#define UPA_J(J) FMAC_BC(S[J], bv, sa, J);
#define UPB_J(J) FMAC_BC(S[J], kdv, vv, J);
#define Y_J(A, J) FMAC_BC(A, rv, S[J], J);

__device__ void scan_phase(const Pm& p, char* smem) {
    const int tid = threadIdx.x, lane = tid & 63, w = tid >> 6, fr = lane & 15, fq = lane >> 4;
    char* ws = p.ws;
    float* cb = (float*)smem;
    float* yp = cb + 2 * 6144;
    float* bp = yp + 2 * 8192;
    float* cp = bp + 4 * 64;
    const bf16_t* Rr = (const bf16_t*)(ws + A1_R);
    const bf16_t* Kk = (const bf16_t*)(ws + A1_K);
    const bf16_t* Vv = (const bf16_t*)(ws + A1_V);
    const bf16_t* TW = (const bf16_t*)(ws + A1_TW);
    const bf16_t* TA = (const bf16_t*)(ws + A1_TA);
    const float* KKN = (const float*)(ws + OFF_KKN);
    const int NCH = PB / 16;
    for (int item = blockIdx.x; item < 256; item += gridDim.x) {
        const int b = item >> 5, dir = (item >> 4) & 1, h = item & 15;
        bf16_t* Y = (bf16_t*)(ws + (dir ? A1_Y1 : A1_Y0));
        float* BS = (float*)(ws + OFF_BS) + (size_t)dir * RT * 16;
        __syncthreads();
        if (w >= 4) {
            const int pw = w - 4, ch = h * 64 + pw * 16 + fq * 4;
            bf16x8 w2f[2], a2f[2];
#pragma unroll
            for (int ks = 0; ks < 2; ++ks) {
                w2f[ks] = *(const bf16x8*)((const bf16_t*)(ws + OFF_W2T) + ((size_t)dir * 1024 + h * 64 + pw * 16 + fr) * 64 + ks * 32 + fq * 8);
                a2f[ks] = *(const bf16x8*)((const bf16_t*)(ws + OFF_A2T) + ((size_t)dir * 1024 + h * 64 + pw * 16 + fr) * 64 + ks * 32 + fq * 8);
            }
            const f32x4 w0v = *(const f32x4*)(p.w0 + dir * 1024 + ch), a0v = *(const f32x4*)(p.a0 + dir * 1024 + ch);
            const f32x4 kkc = *(const f32x4*)(p.k_k + ch), kac = *(const f32x4*)(p.k_a + ch), rkc = *(const f32x4*)(p.r_k + ch);
            const int pt = tid - 256;
            struct Raw { bf16x8 tw0, tw1, ta0, ta1; uint2 k, v, r, k1; float kn, kn1; };
            auto load_raw = [&](int chunk, Raw& q) {
                const int n = chunk * 16 + fr;
                const int pp = n < CTXL ? (dir ? CTXL - 1 - n : n) : (dir ? (PB + CTXL - 1) - n : n);
                const int n1 = n + 1;
                const int pp1 = n1 < CTXL ? (dir ? CTXL - 1 - n1 : n1) : (dir ? (PB + CTXL - 1) - n1 : n1);
                const size_t row = (size_t)b * PB + pp;
                const size_t row1 = (size_t)b * PB + (n1 < PB ? pp1 : pp);
                q.tw0 = *(const bf16x8*)(TW + row * 128 + dir * 64 + fq * 8);
                q.tw1 = *(const bf16x8*)(TW + row * 128 + dir * 64 + 32 + fq * 8);
                q.ta0 = *(const bf16x8*)(TA + row * 128 + dir * 64 + fq * 8);
                q.ta1 = *(const bf16x8*)(TA + row * 128 + dir * 64 + 32 + fq * 8);
                q.k = *(const uint2*)(Kk + row * 1024 + ch);
                q.v = *(const uint2*)(Vv + row * 1024 + ch);
                q.r = *(const uint2*)(Rr + row * 1024 + ch);
                q.k1 = *(const uint2*)(Kk + row1 * 1024 + ch);
                q.kn = KKN[row * 16 + h];
                q.kn1 = n1 < PB ? KKN[row1 * 16 + h] : 0.f;
            };
            Raw cur, nxt;
            load_raw(0, cur);
            nxt = cur;
            for (int c = -1; c < NCH; ++c) {
                if (c + 2 < NCH) load_raw(c + 2, nxt);
                if (c + 1 < NCH) {
                    const int buf = (c + 1) & 1;
                    f32x4 wp = (f32x4){0.f, 0.f, 0.f, 0.f}, ap = (f32x4){0.f, 0.f, 0.f, 0.f};
                    wp = __builtin_amdgcn_mfma_f32_16x16x32_bf16(w2f[0], cur.tw0, wp, 0, 0, 0);
                    wp = __builtin_amdgcn_mfma_f32_16x16x32_bf16(w2f[1], cur.tw1, wp, 0, 0, 0);
                    ap = __builtin_amdgcn_mfma_f32_16x16x32_bf16(a2f[0], cur.ta0, ap, 0, 0, 0);
                    ap = __builtin_amdgcn_mfma_f32_16x16x32_bf16(a2f[1], cur.ta1, ap, 0, 0, 0);
                    const f32x4 k4 = (f32x4){bflo(cur.k.x), bfhi(cur.k.x), bflo(cur.k.y), bfhi(cur.k.y)};
                    const f32x4 v4 = (f32x4){bflo(cur.v.x), bfhi(cur.v.x), bflo(cur.v.y), bfhi(cur.v.y)};
                    const f32x4 r4 = (f32x4){bflo(cur.r.x), bfhi(cur.r.x), bflo(cur.r.y), bfhi(cur.r.y)};
                    const f32x4 k4n = (f32x4){bflo(cur.k1.x), bfhi(cur.k1.x), bflo(cur.k1.y), bfhi(cur.k1.y)};
                    const float kn = cur.kn, kn1 = cur.kn1;
                    f32x4 dec, un4, b4, kd4;
                    float bsum = 0.f, c1 = 0.f, c2 = 0.f;
#pragma unroll
                    for (int j = 0; j < 4; ++j) {
                        const float z = -(w0v[j] + wp[j]);
                        const float sp = fmaxf(z, 0.f) + __logf(1.0f + __expf(-fabsf(z)));
                        const float wl = -sp - 0.5f;
                        dec[j] = __expf(-__expf(wl));
                        const float a = fsigmoid(a0v[j] + ap[j]);
                        kd4[j] = k4[j] * (1.0f + (a - 1.0f) * kac[j]);
                        const float kk = k4[j] * kkc[j] * kn;
                        const float kkn1 = k4n[j] * kkc[j] * kn1;
                        b4[j] = kk * a;
                        un4[j] = dec[j] * kkn1;
                        c1 += b4[j] * kkn1;
                        c2 += kd4[j] * kkn1;
                        bsum += r4[j] * kd4[j] * rkc[j];
                    }
                    f32x4 D = dec;
#pragma unroll
                    for (int dd = 1; dd < 16; dd <<= 1) {
                        f32x4 up;
#pragma unroll
                        for (int j = 0; j < 4; ++j) up[j] = __shfl_up(D[j], dd, 16);
                        if (fr >= dd) D = D * up;
                    }
                    f32x4 invD, Dm1;
#pragma unroll
                    for (int j = 0; j < 4; ++j) { invD[j] = 1.0f / D[j]; Dm1[j] = D[j] / dec[j]; }
                    float* cbb = cb + buf * 6144 + fr * 64 + pw * 16 + fq * 4;
                    *(f32x4*)(cbb + 0 * 1024) = D;
                    *(f32x4*)(cbb + 1 * 1024) = un4 * (-Dm1);
                    *(f32x4*)(cbb + 2 * 1024) = b4 * invD;
                    *(f32x4*)(cbb + 3 * 1024) = kd4 * invD;
                    *(f32x4*)(cbb + 4 * 1024) = r4 * D;
                    *(f32x4*)(cbb + 5 * 1024) = v4;
                    bsum = xsum16_32(bsum);
                    c1 = xsum16_32(c1);
                    c2 = xsum16_32(c2);
                    if (fq == 0) {
                        bp[((c + 1) & 3) * 64 + fr * 4 + pw] = bsum;
                        cp[buf * 128 + fr * 8 + pw * 2] = c1;
                        cp[buf * 128 + fr * 8 + pw * 2 + 1] = c2;
                    }
                }
                if (c >= 1 && (c - 1) * 16 >= CTXL) {
                    const int co = c - 1, buf = co & 1;
                    const int tt = pt >> 4, vq = (pt & 15) * 4, n = co * 16 + tt;
                    const int pp = dir ? (PB + CTXL - 1) - n : n;
                    const float* ypb = yp + buf * 8192 + tt * 512 + vq * 2;
                    f32x4 ya = *(const f32x4*)(ypb), yb = *(const f32x4*)(ypb + 4);
#pragma unroll
                    for (int e = 1; e < 4; ++e) { ya += *(const f32x4*)(ypb + e * 128); yb += *(const f32x4*)(ypb + e * 128 + 4); }
                    f32x4 ys = (f32x4){ya[0] + ya[1], ya[2] + ya[3], yb[0] + yb[1], yb[2] + yb[3]};
                    st4bf(Y + ((size_t)b * SEQL + (pp - CTXL)) * 1024 + h * 64 + vq, ys);
                    if ((pt & 15) == 0) {
                        const float* bb = bp + (co & 3) * 64 + tt * 4;
                        BS[((size_t)b * PB + pp) * 16 + h] = bb[0] + bb[1] + bb[2] + bb[3];
                    }
                }
                __syncthreads();
                cur = nxt;
            }
            {
                const int co = NCH - 1, buf = co & 1;
                const int tt = pt >> 4, vq = (pt & 15) * 4, n = co * 16 + tt;
                const int pp = dir ? (PB + CTXL - 1) - n : n;
                const float* ypb = yp + buf * 8192 + tt * 512 + vq * 2;
                f32x4 ya = *(const f32x4*)(ypb), yb = *(const f32x4*)(ypb + 4);
#pragma unroll
                for (int e = 1; e < 4; ++e) { ya += *(const f32x4*)(ypb + e * 128); yb += *(const f32x4*)(ypb + e * 128 + 4); }
                f32x4 ys = (f32x4){ya[0] + ya[1], ya[2] + ya[3], yb[0] + yb[1], yb[2] + yb[3]};
                st4bf(Y + ((size_t)b * SEQL + (pp - CTXL)) * 1024 + h * 64 + vq, ys);
                if ((pt & 15) == 0) {
                    const float* bb = bp + (co & 3) * 64 + tt * 4;
                    BS[((size_t)b * PB + pp) * 16 + h] = bb[0] + bb[1] + bb[2] + bb[3];
                }
            }
        } else {
            float S[16];
#pragma unroll
            for (int j = 0; j < 16; ++j) S[j] = 0.f;
            float R1 = 0.f, sa_prev = 0.f, v_prev = 0.f, c1p = 0.f, c2p = 0.f;
            float py0 = 0.f, py1 = 0.f, py2 = 0.f, py3 = 0.f;
            const int bpa16 = (lane ^ 16) << 2, bpa32 = (lane ^ 32) << 2;
            __syncthreads();
            for (int c = 0; c < NCH; ++c) {
                const float* cbb = cb + (c & 1) * 6144 + lane;
                const float* cvb = cb + (c & 1) * 6144 + 5 * 1024 + w * 16 + fr;
                const float* cpb = cp + (c & 1) * 128;
                float* ypb = yp + (c & 1) * 8192 + (fq * 64 + w * 16 + fr) * 2;
                float unv_n = cbb[1 * 1024], bv_n = cbb[2 * 1024], kdv_n = cbb[3 * 1024], rv_n = cbb[4 * 1024], vv_n = cvb[0];
                float c1v, c2v;
                {
                    const f32x4 q0 = *(const f32x4*)(cpb + fr * 8), q1 = *(const f32x4*)(cpb + fr * 8 + 4);
                    c1v = -((q0[0] + q0[2]) + (q1[0] + q1[2]));
                    c2v = -((q0[1] + q0[3]) + (q1[1] + q1[3]));
                }
#pragma unroll
                for (int tt = 0; tt < 16; ++tt) {
                    const float unv = unv_n, bv = bv_n, kdv = kdv_n, rv = rv_n, vv = vv_n;
                    if (tt < 15) {
                        unv_n = cbb[1 * 1024 + (tt + 1) * 64]; bv_n = cbb[2 * 1024 + (tt + 1) * 64]; kdv_n = cbb[3 * 1024 + (tt + 1) * 64];
                        rv_n = cbb[4 * 1024 + (tt + 1) * 64]; vv_n = cvb[(tt + 1) * 64];
                    }
                    const float sa = fmaf(v_prev, c2p, fmaf(sa_prev, c1p, R1));
                    float s0, s1, s2, s3;
                    MUL_BC(s0, unv, S[0], 0); MUL_BC(s1, unv, S[1], 1); MUL_BC(s2, unv, S[2], 2); MUL_BC(s3, unv, S[3], 3);
                    R1_J(s0, 4) R1_J(s1, 5) R1_J(s2, 6) R1_J(s3, 7)
                    R1_J(s0, 8) R1_J(s1, 9) R1_J(s2, 10) R1_J(s3, 11) R1_J(s0, 12) R1_J(s1, 13) R1_J(s2, 14) R1_J(s3, 15)
                    UPA_J(0) UPA_J(1) UPA_J(2) UPA_J(3) UPA_J(4) UPA_J(5) UPA_J(6) UPA_J(7)
                    UPA_J(8) UPA_J(9) UPA_J(10) UPA_J(11) UPA_J(12) UPA_J(13) UPA_J(14) UPA_J(15)
                    asm volatile("v_add_f32 %0, %0, %1" : "+v"(s0) : "v"(s1));
                    asm volatile("v_add_f32 %0, %0, %1" : "+v"(s2) : "v"(s3));
                    float t1 = s0;
                    asm volatile("v_add_f32 %0, %0, %1" : "+v"(t1) : "v"(s2));
                    const float x1 = __builtin_bit_cast(float, __builtin_amdgcn_ds_bpermute(bpa16, __builtin_bit_cast(int, t1)));
                    if (tt > 0) {
                        asm volatile("v_add_f32 %0, %0, %1" : "+v"(py0) : "v"(py1));
                        asm volatile("v_add_f32 %0, %0, %1" : "+v"(py2) : "v"(py3));
                        *(float2*)(ypb + (tt - 1) * 512) = make_float2(py0, py2);
                    }
                    UPB_J(0) UPB_J(1) UPB_J(2) UPB_J(3) UPB_J(4) UPB_J(5) UPB_J(6) UPB_J(7)
                    UPB_J(8) UPB_J(9) UPB_J(10) UPB_J(11) UPB_J(12) UPB_J(13) UPB_J(14) UPB_J(15)
                    float t2 = t1;
                    asm volatile("v_add_f32 %0, %0, %1" : "+v"(t2) : "v"(x1));
                    const float x2 = __builtin_bit_cast(float, __builtin_amdgcn_ds_bpermute(bpa32, __builtin_bit_cast(int, t2)));
                    float y0, y1, y2, y3;
                    MUL_BC(y0, rv, S[0], 0); MUL_BC(y1, rv, S[1], 1); MUL_BC(y2, rv, S[2], 2); MUL_BC(y3, rv, S[3], 3);
                    Y_J(y0, 4) Y_J(y1, 5) Y_J(y2, 6) Y_J(y3, 7)
                    Y_J(y0, 8) Y_J(y1, 9) Y_J(y2, 10) Y_J(y3, 11) Y_J(y0, 12) Y_J(y1, 13) Y_J(y2, 14) Y_J(y3, 15)
                    py0 = y0; py1 = y1; py2 = y2; py3 = y3;
                    R1 = t2;
                    asm volatile("v_add_f32 %0, %0, %1" : "+v"(R1) : "v"(x2));
                    sa_prev = sa;
                    v_prev = vv;
                    c1p = __builtin_bit_cast(float, __builtin_amdgcn_readlane(__builtin_bit_cast(int, c1v), tt));
                    c2p = __builtin_bit_cast(float, __builtin_amdgcn_readlane(__builtin_bit_cast(int, c2v), tt));
                }
                {
                    const float dl = cbb[0 * 1024 + 15 * 64];
                    RSC_J(0) RSC_J(1) RSC_J(2) RSC_J(3) RSC_J(4) RSC_J(5) RSC_J(6) RSC_J(7)
                    RSC_J(8) RSC_J(9) RSC_J(10) RSC_J(11) RSC_J(12) RSC_J(13) RSC_J(14) RSC_J(15)
                    asm volatile("v_add_f32 %0, %0, %1" : "+v"(py0) : "v"(py1));
                    asm volatile("v_add_f32 %0, %0, %1" : "+v"(py2) : "v"(py3));
                    *(float2*)(ypb + 15 * 512) = make_float2(py0, py2);
                }
                __syncthreads();
            }
        }
        __syncthreads();
    }
}

#define NPHASE 17
#ifndef PH_MASK
#define PH_MASK 0x1ffff
#endif
#define PHON(n) ((PH_MASK >> (n)) & 1)
#ifndef DBG_ZMASK
#define DBG_ZMASK 0
#endif
template <int PH> __device__ __forceinline__ void run_phase(const Pm& p, char* smem) {
    char* ws = p.ws;
    int tid_l = threadIdx.x;
    asm volatile("" : "+v"(tid_l));
    const int G = gridDim.x, lane = tid_l & 63;
    const float* MOD0 = (const float*)(ws + OFF_MOD);
    const float* MOD1 = MOD0 + 9 * 6144;
    float* XC = (float*)(ws + OFF_XC);
    {
        switch (PH) {
        case 0: if (!PHON(0)) break; phase0(p, smem); break;
        case 1: if (!PHON(1)) break; norm_phase<0>(p.x, p.ctx, p.n1g, MOD0, 0, 1, (bf16_t*)(ws + A0_H), nullptr, false); break;
        case 2: if (!PHON(2)) break; {
            GemmArgs ga{(const bf16_t*)(ws + A0_H), nullptr, nullptr, (const bf16_t*)(ws + OFF_WQKV), 1024, 1024};
            for (int u = blockIdx.x >> 3, tm, tn; xcd_tile(u, 6, false, tm, tn); u += (G >> 3)) {
                f32x4 acc[2][4][4];
                gemm_main<0, 256>(ga, tm, tn, acc, smem);
                for (int hh = 0; hh < 2; ++hh)
                epi_qkv(acc[hh], tm * 256 + GEMM_WROW(256) + hh * 64, tn * 256 + GEMM_WCOL(256), lane, (bf16_t*)(ws + A0_Q), (bf16_t*)(ws + A0_K), (bf16_t*)(ws + A0_VT), p.qg, p.kg,
                        (const float*)(ws + OFF_ROPE));
            }
        } break;
        case 3: if (!PHON(3)) break; attn_phase((const bf16_t*)(ws + A0_Q), (const bf16_t*)(ws + A0_K), (const bf16_t*)(ws + A0_VT), (bf16_t*)(ws + A0_O), p.qg, p.kg, smem); break;
        case 4: if (!PHON(4)) break; {
            GemmArgs ga{(const bf16_t*)(ws + A0_O), nullptr, nullptr, (const bf16_t*)(ws + OFF_AWO), 1024, 1024};
            for (int u = blockIdx.x >> 3, tm, tn; xcd_tile(u, 4, false, tm, tn); u += (G >> 3)) {
                f32x4 acc[2][4][4];
                gemm_main<0, 256>(ga, tm, tn, acc, smem);
                for (int hh = 0; hh < 2; ++hh)
                epi_res(acc[hh], tm * 256 + GEMM_WROW(256) + hh * 64, tn * 256 + GEMM_WCOL(256), lane, p.x, p.ctx, p.out, XC, MOD0, 2, (DBG_ZMASK & 1) ? 0.f : 1.f);
            }
        } break;
        case 5: if (!PHON(5)) break; norm_phase<0>(p.out, XC, p.n2g, MOD0, 3, 4, (bf16_t*)(ws + A0_H), nullptr, false); break;
        case 6: if (!PHON(6)) break; {
            GemmArgs ga{(const bf16_t*)(ws + A0_H), nullptr, nullptr, (const bf16_t*)(ws + OFF_GU), 1024, 1024};
            for (int u = blockIdx.x >> 3, tm, tn; xcd_tile(u, 22, false, tm, tn); u += (G >> 3)) {
                f32x4 acc[2][4][4];
                gemm_main<0, 256>(ga, tm, tn, acc, smem);
                for (int hh = 0; hh < 2; ++hh)
                epi_swiglu(acc[hh], tm * 256 + GEMM_WROW(256) + hh * 64, tn * 256 + GEMM_WCOL(256), lane, (bf16_t*)(ws + A0_ACT));
            }
        } break;
        case 7: if (!PHON(7)) break; {
            GemmArgs ga{(const bf16_t*)(ws + A0_ACT), nullptr, nullptr, (const bf16_t*)(ws + OFF_WD), DFF, DFF};
            for (int u = blockIdx.x >> 3, tm, tn; xcd_tile(u, 4, false, tm, tn); u += (G >> 3)) {
                f32x4 acc[2][4][4];
                gemm_main<0, 256>(ga, tm, tn, acc, smem);
                for (int hh = 0; hh < 2; ++hh)
                epi_res(acc[hh], tm * 256 + GEMM_WROW(256) + hh * 64, tn * 256 + GEMM_WCOL(256), lane, p.out, XC, p.out, XC, MOD0, 5, (DBG_ZMASK & 2) ? 0.f : 1.f);
            }
        } break;
        case 8: if (!PHON(8)) break; norm_phase<1>(p.out, XC, p.n1g + 1024, MOD1, 0, 1, (bf16_t*)(ws + A1_H), (bf16_t*)(ws + A1_XX), false); break;
        case 9: if (!PHON(9)) break; {
            for (int u = blockIdx.x >> 3, tm, r; xcd_tile(u, 12, false, tm, r); u += (G >> 3)) {
                const int jobi = r >> 2, tn = r & 3;
                const int mixrow = jobi == 0 ? 0 : jobi == 1 ? 2 : 3;
                GemmArgs ga{(const bf16_t*)(ws + A1_H), (const bf16_t*)(ws + A1_XX), p.mix + mixrow * 1024,
                            (const bf16_t*)(ws + OFF_WRKV) + (size_t)jobi * 1024 * 1024, 1024, 1024};
                f32x4 acc[2][4][4];
                gemm_main<1, 256>(ga, tm, tn, acc, smem);
                for (int hh = 0; hh < 2; ++hh) {
                    const int row0 = tm * 256 + GEMM_WROW(256) + hh * 64, col0 = tn * 256 + GEMM_WCOL(256);
                    if (jobi == 0) epi_store<0>(acc[hh], row0, col0, lane, (bf16_t*)(ws + A1_R), 1024);
                    else if (jobi == 1) epi_kstore(acc[hh], row0, col0, lane, (bf16_t*)(ws + A1_K), p.k_k, (float*)(ws + OFF_KKN));
                    else epi_store<0>(acc[hh], row0, col0, lane, (bf16_t*)(ws + A1_V), 1024);
                }
            }
            for (int u = ((blockIdx.x >> 3) + 16) & 31, tm, r; xcd_tile(u, 3, false, tm, r); u += (G >> 3)) {
                const int jobi = 3 + r;
                const int mixrow = jobi == 3 ? 1 : jobi == 4 ? 4 : 5;
                GemmArgs ga{(const bf16_t*)(ws + A1_H), (const bf16_t*)(ws + A1_XX), p.mix + mixrow * 1024,
                            (const bf16_t*)(ws + (jobi == 3 ? OFF_W1T : jobi == 4 ? OFF_A1T : OFF_G1T)), 1024, 1024};
                f32x4 acc[1][4][4];
                gemm_main<1, 128>(ga, tm, 0, acc, smem);
                const int row0 = tm * 256 + GEMM_WROW(128), col0 = GEMM_WCOL(128);
                if (jobi == 3) epi_store<1>(acc[0], row0, col0, lane, (bf16_t*)(ws + A1_TW), 128);
                else if (jobi == 4) epi_store<0>(acc[0], row0, col0, lane, (bf16_t*)(ws + A1_TA), 128);
                else epi_store<2>(acc[0], row0, col0, lane, (bf16_t*)(ws + A1_GH), 128);
            }
        } break;
        case 10: if (!PHON(10)) break; scan_phase(p, smem); break;
        case 11: if (!PHON(11)) break; {
            GemmArgs ga{(const bf16_t*)(ws + A1_GH), nullptr, nullptr, (const bf16_t*)(ws + OFF_G2T), 128, 128};
            for (int u = blockIdx.x >> 3, tm, tn; xcd_tile(u, 8, true, tm, tn); u += (G >> 3)) {
                f32x4 acc[1][4][4];
                gemm_main<0, 128>(ga, tm, tn, acc, smem);
                epi_readout(acc[0], tm * 256 + GEMM_WROW(128), tn * 128 + GEMM_WCOL(128), lane, (const bf16_t*)(ws + A1_Y0), (const bf16_t*)(ws + A1_Y1),
                            (const float*)(ws + OFF_BS), (const bf16_t*)(ws + A1_V), p.lng, p.lnb, (bf16_t*)(ws + A1_Z));
            }
        } break;
        case 12: if (!PHON(12)) break; {
            GemmArgs ga{(const bf16_t*)(ws + A1_Z), nullptr, nullptr, (const bf16_t*)(ws + OFF_RWO), 1024, 1024};
            for (int u = blockIdx.x >> 3, tm, tn; xcd_tile(u, 4, true, tm, tn); u += (G >> 3)) {
                f32x4 acc[2][4][4];
                gemm_main<0, 256>(ga, tm, tn, acc, smem);
                for (int hh = 0; hh < 2; ++hh)
                epi_res(acc[hh], tm * 256 + GEMM_WROW(256) + hh * 64, tn * 256 + GEMM_WCOL(256), lane, p.out, XC, p.out, XC, MOD1, 2, (DBG_ZMASK & 4) ? 0.f : 1.f);
            }
        } break;
        case 13: if (!PHON(13)) break; norm_phase<0>(p.out, XC, p.n2g + 1024, MOD1, 3, 4, (bf16_t*)(ws + A1_H2), nullptr, true); break;
        case 14: if (!PHON(14)) break; {
            GemmArgs ga{(const bf16_t*)(ws + A1_H2), nullptr, nullptr, (const bf16_t*)(ws + OFF_GU) + (size_t)5632 * 1024, 1024, 1024};
            for (int u = blockIdx.x >> 3, tm, tn; xcd_tile(u, 22, true, tm, tn); u += (G >> 3)) {
                f32x4 acc[2][4][4];
                gemm_main<0, 256>(ga, tm, tn, acc, smem);
                for (int hh = 0; hh < 2; ++hh)
                epi_swiglu(acc[hh], tm * 256 + GEMM_WROW(256) + hh * 64, tn * 256 + GEMM_WCOL(256), lane, (bf16_t*)(ws + A1_ACT));
            }
        } break;
        case 15: if (!PHON(15)) break; {
            GemmArgs ga{(const bf16_t*)(ws + A1_ACT), nullptr, nullptr, (const bf16_t*)(ws + OFF_WD) + (size_t)1024 * DFF, DFF, DFF};
            for (int u = blockIdx.x >> 3, tm, tn; xcd_tile(u, 4, true, tm, tn); u += (G >> 3)) {
                f32x4 acc[2][4][4];
                gemm_main<0, 256>(ga, tm, tn, acc, smem);
                for (int hh = 0; hh < 2; ++hh)
                epi_res(acc[hh], tm * 256 + GEMM_WROW(256) + hh * 64, tn * 256 + GEMM_WCOL(256), lane, p.out, XC, p.out, XC, MOD1, 5, (DBG_ZMASK & 8) ? 0.f : 1.f);
            }
        } break;
        case 16: if (!PHON(16)) break; final_norm_phase(p.out, p.fg); break;
        default: break;
        }
    }
}


__device__ __forceinline__ void fast_grid_barrier(unsigned* base, unsigned nblocks) {
    __syncthreads();
    if (threadIdx.x == 0) {
        __threadfence();
        const unsigned ngrp = (nblocks & 7u) ? 1u : 8u, grp = (ngrp == 8u) ? (blockIdx.x & 7u) : 0u, per = nblocks / ngrp;
        const unsigned old = __hip_atomic_fetch_add(base + grp * 32, 1u, __ATOMIC_RELAXED, __HIP_MEMORY_SCOPE_AGENT);
        if (old == per - 1) {
            __threadfence();
            __hip_atomic_fetch_add(base + 8 * 32, 1u, __ATOMIC_RELAXED, __HIP_MEMORY_SCOPE_AGENT);
        }
        while (__hip_atomic_load(base + 8 * 32, __ATOMIC_RELAXED, __HIP_MEMORY_SCOPE_AGENT) < ngrp) __builtin_amdgcn_s_sleep(2);
        __threadfence();
    }
    __syncthreads();
}

#define DO_PHASE(n)                                  \
    if (p.plo <= (n) && (n) < p.phi) {               \
        if ((n) > p.plo) { if ((n) == 1) grid.sync(); else fast_grid_barrier((unsigned*)(p.ws + OFF_SYNC) + 512 * (n), gridDim.x); } \
        run_phase<n>(p, smem);                       \
    }
__global__ void __launch_bounds__(NTHR) fwd_kernel(Pm p) {
    extern __shared__ __attribute__((aligned(16))) char smem[];
    cg::grid_group grid = cg::this_grid();
    DO_PHASE(0) DO_PHASE(1) DO_PHASE(2) DO_PHASE(3) DO_PHASE(4) DO_PHASE(5) DO_PHASE(6) DO_PHASE(7) DO_PHASE(8)
    DO_PHASE(9) DO_PHASE(10) DO_PHASE(11) DO_PHASE(12) DO_PHASE(13) DO_PHASE(14) DO_PHASE(15) DO_PHASE(16)
}

extern "C" void kernel_launch(void* const* d_in, const int* in_sizes, int n_in, void* d_out, int out_size, void* d_ws, size_t ws_size, hipStream_t stream) {
    Pm p{};
    const float** pp = (const float**)&p;
    for (int i = 0; i < 32; ++i) pp[i] = (const float*)d_in[i];
    p.out = (float*)d_out;
    p.ws = (char*)d_ws;
    if (ws_size < WS_NEED) fprintf(stderr, "workspace too small: %zu < %zu\n", ws_size, (size_t)WS_NEED);
    static int grid_blocks = 0;
    if (!grid_blocks) {
        hipFuncSetAttribute((const void*)fwd_kernel, hipFuncAttributeMaxDynamicSharedMemorySize, LDS_BYTES);
        int dev = 0, cus = 0, per_cu = 0;
        hipGetDevice(&dev);
        hipDeviceGetAttribute(&cus, hipDeviceAttributeMultiprocessorCount, dev);
        hipOccupancyMaxActiveBlocksPerMultiprocessor(&per_cu, fwd_kernel, NTHR, LDS_BYTES);
        if (per_cu < 1) per_cu = 1;
        grid_blocks = cus * per_cu;
    }
    (void)hipMemsetAsync((char*)d_ws + OFF_SYNC, 0, 2048 * 20, stream);
#if MULTI_LAUNCH
    for (int ph = 0; ph < NPHASE; ++ph) {
        p.plo = ph;
        p.phi = ph + 1;
        hipLaunchKernelGGL(fwd_kernel, dim3(grid_blocks), dim3(NTHR), LDS_BYTES, stream, p);
    }
#else
    p.plo = 0;
    p.phi = NPHASE;
    void* args[] = {&p};
    hipError_t e = hipLaunchCooperativeKernel((void*)fwd_kernel, dim3(grid_blocks), dim3(NTHR), args, LDS_BYTES, stream);
    if (e != hipSuccess) fprintf(stderr, "cooperative launch failed: %s (grid %d)\n", hipGetErrorString(e), grid_blocks);
#endif
}
```
